# Optimizing an MI355X kernel written in HIP

```python
import math
import jax, jax.numpy as jnp
from jax import lax
import numpy as np

D_MODEL = 1024
BATCH = 2
SEQ = 8192
DEPTH = 4
DEC_BATCH = 8
DEC_SEQ = 4096
PAST_LEN = 128

MIX_WIDTH = D_MODEL
DIFF_WIDTH = MIX_WIDTH // 2
RET_WIDTH = MIX_WIDTH - DIFF_WIDTH
DIFF_QK_DIM = 64
DIFF_V_DIM = 2 * DIFF_QK_DIM
DIFF_HEADS = DIFF_WIDTH // DIFF_V_DIM
RET_HEAD_DIM = 64
RET_HEADS = RET_WIDTH // RET_HEAD_DIM
ROT_DIMS = DIFF_QK_DIM // 4
ROPE_THETA = 500000.0
RET_THETA = 10000.0
D_FF = 4 * D_MODEL
PLE_DIM = 256
CHUNK = 128
Q_BLOCK = 128
EPS = 1e-6
IN_WIDTH = 3 * DIFF_WIDTH + 4 * RET_WIDTH
SPLITS = (DIFF_WIDTH, 2 * DIFF_WIDTH, 3 * DIFF_WIDTH,
          3 * DIFF_WIDTH + RET_WIDTH, 3 * DIFF_WIDTH + 2 * RET_WIDTH,
          3 * DIFF_WIDTH + 3 * RET_WIDTH)

kernel_name = 'hybrid_diffattn_retention_encoder'


def rms_norm(x, w):
    xf = x.astype(jnp.float32)
    y = xf * lax.rsqrt(jnp.mean(xf * xf, axis=-1, keepdims=True) + EPS)
    return (y * w.astype(jnp.float32)).astype(x.dtype)


def rotary(x, rot_dims, theta):
    s = x.shape[-2]
    half = rot_dims // 2
    inv = 1.0 / (theta ** (jnp.arange(0, rot_dims, 2, dtype=jnp.float32) / rot_dims))
    ang = jnp.arange(s, dtype=jnp.float32)[:, None] * inv[None, :]
    cos, sin = jnp.cos(ang), jnp.sin(ang)
    xf = x.astype(jnp.float32)
    x1, x2, xp = xf[..., :half], xf[..., half:rot_dims], xf[..., rot_dims:]
    out = jnp.concatenate([x1 * cos - x2 * sin, x1 * sin + x2 * cos, xp], axis=-1)
    return out.astype(x.dtype)


def differential_attention(q, k, v, lam):
    b, h, _, s, d = q.shape
    q = q * (d ** -0.5)
    nq = s // Q_BLOCK
    qb = jnp.moveaxis(q.reshape(b, h, 2, nq, Q_BLOCK, d), 3, 0)

    def block(qi):
        sc = jnp.einsum('bhcqd,bhckd->bhcqk', qi, k).astype(jnp.float32)
        pr = jax.nn.softmax(sc, axis=-1)
        w = pr[:, :, 0] - lam * pr[:, :, 1]
        return jnp.einsum('bhqk,bhke->bhqe', w.astype(v.dtype), v)

    out = lax.map(block, qb)
    return jnp.moveaxis(out, 0, 2).reshape(b, h, s, v.shape[-1])


def retention_chunkwise(q, k, v, log_gamma, strict):
    q = q.astype(jnp.float32)
    k = k.astype(jnp.float32)
    v = v.astype(jnp.float32)
    b, h, s, dk = q.shape
    dv = v.shape[-1]
    n = s // CHUNK
    qc = q.reshape(b, h, n, CHUNK, dk)
    kc = k.reshape(b, h, n, CHUNK, dk)
    vc = v.reshape(b, h, n, CHUNK, dv)
    idx = jnp.arange(CHUNK, dtype=jnp.float32)
    rel = idx[:, None] - idx[None, :]
    mask = (rel > 0) if strict else (rel >= 0)
    lg = log_gamma[:, None, None]
    dmat = jnp.exp(jnp.where(mask[None], rel[None] * lg, -jnp.inf))
    scores = jnp.einsum('bhncd,bhnmd->bhncm', qc, kc) * dmat[None, :, None]
    inner = jnp.einsum('bhncm,bhnme->bhnce', scores, vc)
    lg1 = log_gamma[:, None]
    k_decay = jnp.exp((CHUNK - 1.0 - idx)[None, :] * lg1)
    kv = jnp.einsum('bhncd,bhnce->bhnde', kc * k_decay[None, :, None, :, None], vc)
    chunk_decay = jnp.exp(CHUNK * log_gamma)[None, :, None, None]

    def step(state, kv_i):
        return state * chunk_decay + kv_i, state

    init = jnp.zeros((b, h, dk, dv), jnp.float32)
    _, prev = lax.scan(step, init, jnp.moveaxis(kv, 2, 0))
    prev = jnp.moveaxis(prev, 0, 2)
    q_decay = jnp.exp((idx + 1.0)[None, :] * lg1)
    cross = jnp.einsum('bhncd,bhnde->bhnce', qc * q_decay[None, :, None, :, None], prev)
    return (inner + cross).reshape(b, h, s, dv)


def encoder_layer(x, p_i, layer_idx, ln1_w, w_in, q_norm_w, k_norm_w, lam_p, subln_w,
                  decay_logit, gn_w, w_out, ln2_w, w1, w2, wg, wp):
    b, s, _ = x.shape
    hn = rms_norm(x, ln1_w)
    proj = hn @ w_in
    dq, dk, dv, rq, rk, rv, rg = jnp.split(proj, SPLITS, axis=-1)

    dq = rms_norm(dq.reshape(b, s, DIFF_HEADS, 2, DIFF_QK_DIM), q_norm_w)
    dk = rms_norm(dk.reshape(b, s, DIFF_HEADS, 2, DIFF_QK_DIM), k_norm_w)
    dq = rotary(jnp.transpose(dq, (0, 2, 3, 1, 4)), ROT_DIMS, ROPE_THETA)
    dk = rotary(jnp.transpose(dk, (0, 2, 3, 1, 4)), ROT_DIMS, ROPE_THETA)
    dv = dv.reshape(b, s, DIFF_HEADS, DIFF_V_DIM).transpose(0, 2, 1, 3)
    lam_init = 0.8 - 0.6 * math.exp(-0.3 * layer_idx)
    lp = lam_p.astype(jnp.float32)
    lam = jnp.exp(jnp.sum(lp[0] * lp[1])) - jnp.exp(jnp.sum(lp[2] * lp[3])) + lam_init
    a = differential_attention(dq, dk, dv, lam)
    a = rms_norm(a, subln_w) * (1.0 - lam_init)
    a = a.transpose(0, 2, 1, 3).reshape(b, s, DIFF_WIDTH).astype(x.dtype)

    rq = rotary(rq.reshape(b, s, RET_HEADS, RET_HEAD_DIM).transpose(0, 2, 1, 3), RET_HEAD_DIM, RET_THETA)
    rk = rotary(rk.reshape(b, s, RET_HEADS, RET_HEAD_DIM).transpose(0, 2, 1, 3), RET_HEAD_DIM, RET_THETA)
    rk = rk * (RET_HEAD_DIM ** -0.5)
    rv = rv.reshape(b, s, RET_HEADS, RET_HEAD_DIM).transpose(0, 2, 1, 3)
    lg = jax.nn.log_sigmoid(decay_logit.astype(jnp.float32))
    fwd = retention_chunkwise(rq, rk, rv, lg[0], False)
    bwd = jnp.flip(retention_chunkwise(jnp.flip(rq, 2), jnp.flip(rk, 2), jnp.flip(rv, 2), lg[1], True), 2)
    r = rms_norm(fwd + bwd, gn_w).astype(x.dtype)
    r = r.transpose(0, 2, 1, 3).reshape(b, s, RET_WIDTH)
    r = jax.nn.silu(rg) * r

    x = x + jnp.concatenate([a, r], axis=-1) @ w_out

    h2 = rms_norm(x, ln2_w)
    x = x + jnp.square(jax.nn.relu(h2 @ w1)) @ w2

    x = x + jax.nn.sigmoid(x @ wg) * (p_i @ wp)
    return x


def run_trunk(x, p, ln1_w, w_in, diff_q_norm, diff_k_norm, diff_lambda, diff_subln,
              ret_decay_logit, ret_gn, w_out, ln2_w, w_mlp1, w_mlp2, w_ple_gate, w_ple_proj):
    for i in range(DEPTH):
        x = encoder_layer(x, p[i], i, ln1_w[i], w_in[i], diff_q_norm[i], diff_k_norm[i],
                          diff_lambda[i], diff_subln[i], ret_decay_logit[i], ret_gn[i],
                          w_out[i], ln2_w[i], w_mlp1[i], w_mlp2[i], w_ple_gate[i], w_ple_proj[i])
    return x


def setup_inputs(seed: int = 0) -> dict:
    key = jax.random.key(seed)
    ks = jax.random.split(key, 20)
    f32 = jnp.float32
    nrm = lambda k, shape, scale: jax.random.normal(k, shape, f32) * scale
    base_logit = jnp.log(2.0 ** (5.0 + jnp.arange(RET_HEADS, dtype=f32)) - 1.0)
    return {
        'x_prompt': nrm(ks[0], (BATCH, SEQ, D_MODEL), 1.0),
        'x_sample': nrm(ks[1], (DEC_BATCH, DEC_SEQ, D_MODEL), 1.0),
        'p_prompt': nrm(ks[2], (DEPTH, BATCH, SEQ, PLE_DIM), 1.0),
        'p_sample': nrm(ks[3], (DEPTH, DEC_BATCH, DEC_SEQ, PLE_DIM), 1.0),
        'ln1_w': 1.0 + nrm(ks[4], (DEPTH, D_MODEL), 0.02),
        'w_in': nrm(ks[5], (DEPTH, D_MODEL, IN_WIDTH), D_MODEL ** -0.5),
        'diff_q_norm': 1.0 + nrm(ks[6], (DEPTH, DIFF_QK_DIM), 0.02),
        'diff_k_norm': 1.0 + nrm(ks[7], (DEPTH, DIFF_QK_DIM), 0.02),
        'diff_lambda': nrm(ks[8], (DEPTH, 4, DIFF_QK_DIM), 0.1),
        'diff_subln': 1.0 + nrm(ks[9], (DEPTH, DIFF_V_DIM), 0.02),
        'ret_decay_logit': base_logit[None, None, :] + nrm(ks[10], (DEPTH, 2, RET_HEADS), 0.1),
        'ret_gn': 1.0 + nrm(ks[11], (DEPTH, RET_HEAD_DIM), 0.02),
        'w_out': nrm(ks[12], (DEPTH, MIX_WIDTH, D_MODEL), MIX_WIDTH ** -0.5),
        'ln2_w': 1.0 + nrm(ks[13], (DEPTH, D_MODEL), 0.02),
        'w_mlp1': nrm(ks[14], (DEPTH, D_MODEL, D_FF), D_MODEL ** -0.5),
        'w_mlp2': nrm(ks[15], (DEPTH, D_FF, D_MODEL), D_FF ** -0.5),
        'w_ple_gate': nrm(ks[16], (DEPTH, D_MODEL, D_MODEL), D_MODEL ** -0.5),
        'w_ple_proj': nrm(ks[17], (DEPTH, PLE_DIM, D_MODEL), PLE_DIM ** -0.5),
    }


def reference(x_prompt, x_sample, p_prompt, p_sample, ln1_w, w_in, diff_q_norm, diff_k_norm,
              diff_lambda, diff_subln, ret_decay_logit, ret_gn, w_out, ln2_w, w_mlp1, w_mlp2,
              w_ple_gate, w_ple_proj):
    y_prompt = run_trunk(x_prompt, p_prompt, ln1_w, w_in, diff_q_norm, diff_k_norm, diff_lambda,
                         diff_subln, ret_decay_logit, ret_gn, w_out, ln2_w, w_mlp1, w_mlp2,
                         w_ple_gate, w_ple_proj)
    y_sample = run_trunk(x_sample, p_sample, ln1_w, w_in, diff_q_norm, diff_k_norm, diff_lambda,
                         diff_subln, ret_decay_logit, ret_gn, w_out, ln2_w, w_mlp1, w_mlp2,
                         w_ple_gate, w_ple_proj)
    return (y_prompt, y_sample)
```

```cpp
#include <hip/hip_runtime.h>
#include <hip/hip_cooperative_groups.h>
#include <cstdio>
#include <cstdint>
namespace cg = cooperative_groups;
namespace pg8 {
#define PG8_LAS __attribute__((address_space(3)))
typedef unsigned short bf16_t;
typedef short bf16x8 __attribute__((ext_vector_type(8)));
typedef float f32x4 __attribute__((ext_vector_type(4)));
typedef unsigned u32x4 __attribute__((ext_vector_type(4)));
constexpr int BM = 256, BK = 64, HALF = 128, HTB = HALF * BK * 2  , STAGE_BYTES = 8 * HTB, NXCD = 8, WGM = 8;

__host__ __device__ __forceinline__ int lds_byte(int r, int c) { const int st = (r >> 4) * 2 + (c >> 5), rr = r & 15, cc = c & 31, ob = rr * 64 + cc * 2; return st * 1024 + (ob ^ (((ob >> 9) & 1) << 5)); }
__host__ __device__ __forceinline__ void stage_rc(int b, int& R, int& C) { const int st = b / 1024, sb = b % 1024, swz = sb ^ (((sb >> 9) & 1) << 5); R = (st >> 1) * 16 + swz / 64; C = (st & 1) * 32 + (swz % 64) / 2; }
__host__ __device__ __forceinline__ int perm32(int rho) { const int n = rho >> 4, i = rho & 15; return 8 * (i >> 2) + 4 * n + (i & 3); }

struct Unit { int pm, pn; };
struct Gemm { const bf16_t* A; const bf16_t* Bt; int M, N, K; };

struct StaticOrder {
    int nM, nN, nwg, G, c;
    __host__ __device__ void init(int M, int N, int G_, int c_) { nM = M / BM; nN = N / BM; nwg = nM * nN; G = G_; c = c_; }
    __host__ __device__ bool next(int i, Unit& u) const {
        const long L = (long)i * G + c; if (L >= nwg) return false;
        int wgid = (int)L; { const int q = nwg / NXCD, r = nwg % NXCD, xcd = wgid % NXCD, off = wgid / NXCD; wgid = (xcd < r ? xcd * (q + 1) : r * (q + 1) + (xcd - r) * q) + off; }
        const int nig = WGM * nN, gid = wgid / nig, fm = gid * WGM, gsz = (nM - fm) < WGM ? (nM - fm) : WGM;
        u.pm = fm + ((wgid % nig) % gsz); u.pn = (wgid % nig) / gsz; return true;
    }
    __device__ __forceinline__ void a_ready(const Unit&) const {}
    __device__ __forceinline__ void done(const Unit&) const {}
};

__device__ __forceinline__ unsigned cvt_pk_bf16(float lo, float hi) { unsigned r; asm volatile("v_cvt_pk_bf16_f32 %0, %1, %2" : "=v"(r) : "v"(lo), "v"(hi)); return r; }
template <class Epi, class Sched, bool ALIGN_EPI = false, bool SP2 = false>
__device__ __forceinline__ void gemm_phase(PG8_LAS unsigned char* lds, const Gemm g, const Sched& S, const Epi& E, const int tid) {
    const int wid = __builtin_amdgcn_readfirstlane(tid >> 6), lane = tid & 63, wr = wid >> 2, wc = wid & 3, fr = lane & 15, fq = lane >> 4;
    const int K = g.K, nt = K / BK;
    unsigned voffA[2], voffB[2];
#pragma unroll
    for (int i = 0; i < 2; ++i) { int R, C; stage_rc(tid * 16 + i * 8192, R, C); const int Rb = Epi::PERM ? ((R & ~31) + perm32(R & 31)) : R;
        voffA[i] = (unsigned)(R * K + C) * 2u; voffB[i] = (unsigned)(Rb * K + C) * 2u; }
    const size_t kstep = (size_t)(BK * 2);
    const size_t hstep = (size_t)HALF * K * 2;
    const size_t tstep = 2 * hstep;
    const unsigned ldsw = (unsigned)wid * 1024u;
    const int aoff = lds_byte(wr * 64 + fr, fq * 8), boff = lds_byte(wc * 32 + fr, fq * 8);
#define PG8_SA(b, h) (((b) * 2 + (h)) * HTB)
#define PG8_SB(b, h) ((4 + (b) * 2 + (h)) * HTB)
#define PG8_STAGE(bufoff, gbase, voff) do { _Pragma("unroll") for (int _i = 0; _i < 2; ++_i) \
        __builtin_amdgcn_global_load_lds((const unsigned*)((const char*)(gbase) + (voff)[_i]), (PG8_LAS unsigned*)(lds + (bufoff) + ldsw + _i * 8192), 16, 0, 0); } while (0)
#define PG8_LDA(dst, b, h) do { _Pragma("unroll") for (int m = 0; m < 4; ++m) _Pragma("unroll") for (int k = 0; k < 2; ++k) dst[m][k] = *(const PG8_LAS bf16x8*)(lds + PG8_SA(b, h) + aoff + m * 2048 + k * 1024); } while (0)
#define PG8_LDB(dst, b, h) do { _Pragma("unroll") for (int n = 0; n < 2; ++n) _Pragma("unroll") for (int k = 0; k < 2; ++k) dst[n][k] = *(const PG8_LAS bf16x8*)(lds + PG8_SB(b, h) + boff + n * 2048 + k * 1024); } while (0)
#define PG8_MMA(ai, bj, At, Bt) do { __builtin_amdgcn_s_setprio(1); _Pragma("unroll") for (int m = 0; m < 4; ++m) _Pragma("unroll") for (int n = 0; n < 2; ++n) _Pragma("unroll") for (int k = 0; k < 2; ++k) \
        acc[ai][bj][m][n] = __builtin_amdgcn_mfma_f32_16x16x32_bf16(Bt[n][k], At[m][k], acc[ai][bj][m][n], 0, 0, 0); __builtin_amdgcn_s_setprio(0); } while (0)
#define PG8_WAIT_V(n) asm volatile("s_waitcnt vmcnt(" #n ")" ::: "memory")
#define PG8_WAIT_L(n) asm volatile("s_waitcnt lgkmcnt(" #n ")" ::: "memory")
#define PG8_BAR __builtin_amdgcn_s_barrier()
#define PG8_SCHED __builtin_amdgcn_sched_barrier(0)
    Unit cur, nxt; int ui = 0;
    if (!S.next(0, cur)) return;
    f32x4 acc[2][2][4][2];
#pragma unroll
    for (int a = 0; a < 2; ++a)
#pragma unroll
        for (int b = 0; b < 2; ++b)
#pragma unroll
            for (int m = 0; m < 4; ++m)
#pragma unroll
                for (int n = 0; n < 2; ++n) acc[a][b][m][n] = (f32x4){0.f, 0.f, 0.f, 0.f};
    bf16x8 At[4][2], B0[2][2], B1[2][2];
    const char* cA = (const char*)g.A + (size_t)cur.pm * tstep; const char* cB = (const char*)g.Bt + (size_t)cur.pn * tstep;
    S.a_ready(cur);
    if constexpr (SP2) {
        PG8_STAGE(PG8_SB(0, 0), cB, voffB); PG8_STAGE(PG8_SB(0, 1), cB + hstep, voffB); PG8_STAGE(PG8_SA(0, 0), cA, voffA); PG8_STAGE(PG8_SA(0, 1), cA + hstep, voffA);
        if (wr == 1) PG8_BAR;
        PG8_WAIT_V(2); PG8_BAR;
        PG8_STAGE(PG8_SB(1, 0), cB + kstep, voffB); PG8_STAGE(PG8_SA(1, 0), cA + kstep, voffA); PG8_STAGE(PG8_SB(1, 1), cB + hstep + kstep, voffB);
        PG8_WAIT_V(6); PG8_BAR;
    } else {
        PG8_STAGE(PG8_SB(0, 0), cB, voffB); PG8_STAGE(PG8_SA(0, 0), cA, voffA); PG8_STAGE(PG8_SB(0, 1), cB + hstep, voffB); PG8_STAGE(PG8_SA(0, 1), cA + hstep, voffA);
        if (wr == 1) PG8_BAR;
        PG8_WAIT_V(4); PG8_BAR;
        PG8_STAGE(PG8_SB(1, 0), cB + kstep, voffB); PG8_STAGE(PG8_SA(1, 0), cA + kstep, voffA); PG8_STAGE(PG8_SB(1, 1), cB + hstep + kstep, voffB);
        PG8_WAIT_V(6); PG8_BAR;
    }
    for (;;) {
        const bool has_next = S.next(ui + 1, nxt);
        const char* nA = has_next ? (const char*)g.A + (size_t)nxt.pm * tstep : cA; const char* nB = has_next ? (const char*)g.Bt + (size_t)nxt.pn * tstep : cB;
        for (int t = 0; t < nt; t += 2) {
            const bool last = (t == nt - 2);
            const char* a1 = cA + (size_t)(t + 1) * kstep;
            const char* a2 = last ? nA : cA + (size_t)(t + 2) * kstep; const char* b2 = last ? nB : cB + (size_t)(t + 2) * kstep;
            const char* a3 = a2 + kstep; const char* b3 = b2 + kstep;
            if (last && has_next) S.a_ready(nxt);
            if constexpr (SP2) {
            PG8_LDB(B0, 0, 0); PG8_LDB(B1, 0, 1); PG8_SCHED; PG8_LDA(At, 0, 0); PG8_STAGE(PG8_SA(1, 1), a1 + hstep, voffA);
            PG8_WAIT_V(8); PG8_WAIT_L(0); PG8_BAR; PG8_MMA(0, 0, At, B0); PG8_MMA(0, 1, At, B1); PG8_BAR; PG8_SCHED;
            PG8_LDA(At, 0, 1); PG8_STAGE(PG8_SB(0, 0), b2, voffB); PG8_STAGE(PG8_SB(0, 1), b2 + hstep, voffB); PG8_STAGE(PG8_SA(0, 0), a2, voffA);
            PG8_WAIT_V(8); PG8_WAIT_L(0); PG8_BAR; PG8_MMA(1, 0, At, B0); PG8_MMA(1, 1, At, B1); PG8_BAR; PG8_SCHED;
            PG8_LDB(B0, 1, 0); PG8_LDB(B1, 1, 1); PG8_SCHED; PG8_LDA(At, 1, 0); PG8_STAGE(PG8_SA(0, 1), a2 + hstep, voffA);
            PG8_WAIT_V(8); PG8_WAIT_L(0); PG8_BAR; PG8_MMA(0, 0, At, B0); PG8_MMA(0, 1, At, B1); PG8_BAR; PG8_SCHED;
            PG8_LDA(At, 1, 1); PG8_STAGE(PG8_SB(1, 0), b3, voffB); PG8_STAGE(PG8_SB(1, 1), b3 + hstep, voffB); PG8_STAGE(PG8_SA(1, 0), a3, voffA);
            PG8_WAIT_V(8); PG8_WAIT_L(0); PG8_BAR; PG8_MMA(1, 0, At, B0); PG8_MMA(1, 1, At, B1); PG8_BAR; PG8_SCHED;
            } else {
            PG8_LDB(B0, 0, 0); PG8_SCHED; PG8_LDA(At, 0, 0); PG8_STAGE(PG8_SA(1, 1), a1 + hstep, voffA);
            PG8_WAIT_L(8); PG8_BAR; PG8_WAIT_L(0); PG8_MMA(0, 0, At, B0); PG8_BAR; PG8_SCHED;
            PG8_LDB(B1, 0, 1); PG8_STAGE(PG8_SB(0, 0), b2, voffB);
            PG8_BAR; PG8_WAIT_L(0); PG8_MMA(0, 1, At, B1); PG8_BAR;
            PG8_LDA(At, 0, 1); PG8_STAGE(PG8_SA(0, 0), a2, voffA);
            PG8_BAR; PG8_WAIT_L(0); PG8_MMA(1, 0, At, B0); PG8_BAR; PG8_SCHED;
            PG8_STAGE(PG8_SB(0, 1), b2 + hstep, voffB);
            PG8_WAIT_V(6); PG8_BAR; PG8_MMA(1, 1, At, B1); PG8_BAR;
            PG8_LDB(B0, 1, 0); PG8_SCHED; PG8_LDA(At, 1, 0); PG8_STAGE(PG8_SA(0, 1), a2 + hstep, voffA);
            PG8_WAIT_L(8); PG8_BAR; PG8_WAIT_L(0); PG8_MMA(0, 0, At, B0); PG8_BAR; PG8_SCHED;
            PG8_LDB(B1, 1, 1); PG8_STAGE(PG8_SB(1, 0), b3, voffB);
            PG8_BAR; PG8_WAIT_L(0); PG8_MMA(0, 1, At, B1); PG8_BAR;
            PG8_LDA(At, 1, 1); PG8_STAGE(PG8_SA(1, 0), a3, voffA);
            PG8_BAR; PG8_WAIT_L(0); PG8_MMA(1, 0, At, B0); PG8_BAR; PG8_SCHED;
            PG8_STAGE(PG8_SB(1, 1), b3 + hstep, voffB);
            PG8_WAIT_V(6); PG8_BAR; PG8_MMA(1, 1, At, B1); PG8_BAR;
            }
        }
        if constexpr (ALIGN_EPI) { if (wr == 0) PG8_BAR; }
        if constexpr (!Epi::AFTER_DRAIN) { E(acc, cur, wr, wc, fr, fq); S.done(cur); }
        if (!has_next) break;
#pragma unroll
        for (int a = 0; a < 2; ++a)
#pragma unroll
            for (int b = 0; b < 2; ++b)
#pragma unroll
                for (int m = 0; m < 4; ++m)
#pragma unroll
                    for (int n = 0; n < 2; ++n) acc[a][b][m][n] = (f32x4){0.f, 0.f, 0.f, 0.f};
        cur = nxt; cA = nA; cB = nB; ++ui;
        if constexpr (ALIGN_EPI) { if (wr == 1) PG8_BAR; }
    }
    PG8_WAIT_V(0);
    if constexpr (!ALIGN_EPI) { if (wr == 0) PG8_BAR; }
    PG8_BAR;
    if constexpr (Epi::AFTER_DRAIN) { E.fused(acc, cur, wr, wc, fr, fq, lds, wid, lane); S.done(cur); }
#undef PG8_SA
#undef PG8_SB
#undef PG8_STAGE
#undef PG8_LDA
#undef PG8_LDB
#undef PG8_MMA
#undef PG8_WAIT_V
#undef PG8_WAIT_L
#undef PG8_BAR
#undef PG8_SCHED
}
}
#define DI __device__ __forceinline__
#define LAS __attribute__((address_space(3)))
typedef unsigned short bf16_t;
typedef short bf16x8 __attribute__((ext_vector_type(8)));
typedef short s16x4 __attribute__((ext_vector_type(4)));
typedef float f32x4 __attribute__((ext_vector_type(4)));
typedef float f32x16 __attribute__((ext_vector_type(16)));
typedef unsigned u32x4 __attribute__((ext_vector_type(4)));
typedef unsigned u32x2 __attribute__((ext_vector_type(2)));

constexpr int DM = 1024, NIN = 3584, DFF = 4096, PLE = 256, DEPTH = 4;
constexpr int MIXW = 1024, RESTW = 2560;
constexpr int R_DK = 0, R_DV = 512, R_RK = 1024, R_RV = 1536, R_RG = 2048;
constexpr float EPSN = 1e-6f;
constexpr float LOG2E = 1.4426950408889634f;
constexpr int NTHREADS = 512, NWAVES = 8;
constexpr int LDS_BYTES = 147456;
constexpr int MAXM = 32768;

constexpr size_t WL_IN = 0, WL_OUT = WL_IN + (size_t)NIN * DM, WL_1 = WL_OUT + (size_t)DM * DM, WL_2 = WL_1 + (size_t)DFF * DM,
                 WL_G = WL_2 + (size_t)DM * DFF, WL_P = WL_G + (size_t)DM * DM, WL_SIZE = WL_P + (size_t)DM * PLE;
constexpr size_t OFF_WT = 0;
constexpr size_t OFF_XBA = OFF_WT + WL_SIZE * 2 * DEPTH;
constexpr size_t OFF_XBB = OFF_XBA + (size_t)MAXM * DM * 2;
constexpr size_t OFF_BIG = OFF_XBB + (size_t)MAXM * DM * 2;
constexpr size_t BIG_MIX = 0, BIG_REST = (size_t)MAXM * MIXW * 2, BIG_ST = BIG_REST + (size_t)MAXM * RESTW * 2;
constexpr size_t BIG_SIZE = BIG_ST + (size_t)(MAXM / 128) * 8 * 2 * 4096 * 4;
constexpr size_t OFF_PB = OFF_BIG + BIG_SIZE;
constexpr size_t OFF_RSQ1 = OFF_PB + (size_t)MAXM * PLE * 2;
constexpr size_t OFF_RSQ2 = OFF_RSQ1 + (size_t)MAXM * 16 * 4;
constexpr size_t OFF_ST16 = OFF_RSQ2 + (size_t)MAXM * 16 * 4;
constexpr size_t OFF_CTL = OFF_ST16 + (size_t)(MAXM / 128) * 8 * 2 * 4096 * 2;
constexpr size_t CTL_BYTES = 16384;
constexpr size_t OFF_TRIGR = OFF_CTL + 65536;
constexpr size_t OFF_TRIGD = OFF_TRIGR + (size_t)8192 * 64 * 4;
constexpr size_t OFF_DUMMY = OFF_TRIGD + (size_t)8192 * 16 * 4;
constexpr size_t WS_NEED = OFF_DUMMY + (1u << 20);
static_assert((size_t)MAXM * DFF * 2 <= BIG_SIZE, "hmid overlays proj + states");

__device__ const float ROT_D[8] = {1.f, 0.193922758f, 0.0376060307f, 0.00729266508f, 0.00141421345f, 0.000274248188f, 5.31829646e-05f, 1.03133852e-05f};
__device__ const float ROT_R[32] = {1.f, 0.749894202f, 0.562341332f, 0.421696514f, 0.316227764f, 0.237137392f, 0.177827939f, 0.133352146f, 0.100000001f, 0.0749894157f, 0.0562341288f, 0.0421696492f, 0.0316227786f, 0.0237137359f, 0.0177827943f, 0.0133352149f, 0.00999999978f, 0.00749894232f, 0.00562341325f, 0.00421696482f, 0.00316227786f, 0.00237137382f, 0.00177827943f, 0.00133352145f, 0.00100000005f, 0.000749894185f, 0.000562341302f, 0.000421696546f, 0.000316227786f, 0.000237137385f, 0.00017782794f, 0.00013335215f};

struct Params {
    const float* x_in[2]; const float* p_in[2];
    const float *ln1, *w_in, *qn, *kn, *lam, *subln, *decay, *gn, *w_out, *ln2, *w1, *w2, *wg, *wp;
    float* out; unsigned char* ws;
    int step_lo, step_hi;
};

DI unsigned pk2(float lo, float hi) { typedef float f2 __attribute__((ext_vector_type(2))); typedef __bf16 b2 __attribute__((ext_vector_type(2))); f2 v = {lo, hi}; b2 b = __builtin_convertvector(v, b2); return __builtin_bit_cast(unsigned, b); }
DI float bf_lo(unsigned w) { return __uint_as_float(w << 16); }
DI float bf_hi(unsigned w) { return __uint_as_float(w & 0xffff0000u); }
DI float bf1(bf16_t h) { return __uint_as_float(((unsigned)h) << 16); }
DI bf16_t f2bf1(float f) { return (bf16_t)(pk2(f, 0.f) & 0xffffu); }
DI int crow(int r, int hi) { return (r & 3) + 8 * (r >> 2) + 4 * hi; }
DI float wave_sum(float v) {
#pragma unroll
    for (int o = 1; o < 64; o <<= 1) v += __shfl_xor(v, o);
    return v;
}
DI float wave_max(float v) {
#pragma unroll
    for (int o = 1; o < 64; o <<= 1) v = fmaxf(v, __shfl_xor(v, o));
    return v;
}
DI float half_sum32(float v) {
#pragma unroll
    for (int o = 1; o < 32; o <<= 1) v += __shfl_xor(v, o);
    return v;
}
DI s16x4 vtr(const LAS unsigned char* p) { typedef short v4i16_t __attribute__((ext_vector_type(4))); return __builtin_bit_cast(s16x4, __builtin_amdgcn_ds_read_tr16_b64_v4i16((LAS v4i16_t*)p)); }
DI bf16x8 cat8(s16x4 lo, s16x4 hi) { return (bf16x8){lo[0], lo[1], lo[2], lo[3], hi[0], hi[1], hi[2], hi[3]}; }
#define MFMA32(a, b, c) __builtin_amdgcn_mfma_f32_32x32x16_bf16((a), (b), (c), 0, 0, 0)
DI bf16x8 pack8(const f32x16& x, int s) {
    u32x4 p; p.x = pk2(x[8 * s], x[8 * s + 1]); p.y = pk2(x[8 * s + 2], x[8 * s + 3]); p.z = pk2(x[8 * s + 4], x[8 * s + 5]); p.w = pk2(x[8 * s + 6], x[8 * s + 7]);
    return __builtin_bit_cast(bf16x8, p);
}
DI float rowscale(const float* rsq, int row) {
    const f32x4* p = (const f32x4*)(rsq + (size_t)row * 16);
    f32x4 a = p[0], b = p[1], c = p[2], d = p[3];
    float s = ((a.x + a.y) + (a.z + a.w)) + ((b.x + b.y) + (b.z + b.w)) + ((c.x + c.y) + (c.z + c.w)) + ((d.x + d.y) + (d.z + d.w));
    return rsqrtf(s * (1.0f / DM) + EPSN);
}

constexpr int RINV_OFF = 131072, RINV_SLOTS = 8;
using pg8::Unit; using pg8::BM; using pg8::HALF; using pg8::cvt_pk_bf16;
DI int pi_diff(int s) { return s < 8 ? s : (s < 32 ? s + 8 : (s < 40 ? s - 24 : s)); }
struct EpiProj {
    static constexpr bool PERM = true, AFTER_DRAIN = false;
    bf16_t* mix; bf16_t* rest; const float* rsq; const float* qnw; const float* knw; const float* trigD; const float* trigR; int smask; const LAS float* rtab; mutable int ui;
    DI void operator()(const f32x4 (&acc)[2][2][4][2], const Unit& u, int wr, int wc, int fr, int fq) const {
        const int row0 = u.pm * BM + wr * 64 + fr; const int type = u.pn >> 1; const int slot = ui++; const LAS float* rt = rtab + slot * 256 + wr * 64 + fr;
        bf16_t* base; int ld, colt;
        if (u.pn < 4) { base = mix; ld = MIXW; colt = u.pn * BM; } else { base = rest; ld = RESTW; colt = (u.pn - 4) * BM; }
        const int col0 = colt + 64 * wc + 8 * fq;
        const bool isnorm = (type == 0) || (type == 2), isrot = (type == 1) || (type == 4);
        const float osc = type == 0 ? (0.125f * LOG2E) : (type == 4 ? 0.125f : 1.0f);
        f32x4 w[2][2];
        if (isnorm) { const float* wp = type == 0 ? qnw : knw;
#pragma unroll
            for (int bj = 0; bj < 2; ++bj)
#pragma unroll
                for (int n = 0; n < 2; ++n)
#pragma unroll
                    for (int j = 0; j < 4; ++j) w[bj][n][j] = wp[pi_diff(32 * bj + 8 * fq + 4 * n + j)]; }
#pragma unroll
        for (int ai = 0; ai < 2; ++ai)
#pragma unroll
            for (int m = 0; m < 4; ++m) {
                const int row = row0 + ai * HALF + m * 16; const float ri = slot < RINV_SLOTS ? rt[ai * HALF + m * 16] : rowscale(rsq, row); const int pos = row & smask;
                f32x4 v[2][2];
#pragma unroll
                for (int bj = 0; bj < 2; ++bj)
#pragma unroll
                    for (int n = 0; n < 2; ++n) v[bj][n] = acc[ai][bj][m][n] * ri;
                if (isnorm) {
                    float ss = 0.f;
#pragma unroll
                    for (int bj = 0; bj < 2; ++bj)
#pragma unroll
                        for (int n = 0; n < 2; ++n) ss += (v[bj][n][0] * v[bj][n][0] + v[bj][n][1] * v[bj][n][1]) + (v[bj][n][2] * v[bj][n][2] + v[bj][n][3] * v[bj][n][3]);
                    ss += __shfl_xor(ss, 16); ss += __shfl_xor(ss, 32);
                    const float rn = rsqrtf(ss * (1.0f / 64.0f) + EPSN);
#pragma unroll
                    for (int bj = 0; bj < 2; ++bj)
#pragma unroll
                        for (int n = 0; n < 2; ++n) v[bj][n] = v[bj][n] * rn * w[bj][n];
                    if (fq == 0) { const float* t = trigD + (size_t)pos * 16;
#pragma unroll
                        for (int n = 0; n < 2; ++n) { const f32x4 c4 = *(const f32x4*)(t + 4 * n), s4 = *(const f32x4*)(t + 8 + 4 * n); const f32x4 x1 = v[0][n], x2 = v[1][n];
                            v[0][n] = x1 * c4 - x2 * s4; v[1][n] = x1 * s4 + x2 * c4; } }
                } else if (isrot) { const float* t = trigR + (size_t)pos * 64 + 8 * fq;
#pragma unroll
                    for (int n = 0; n < 2; ++n) { const f32x4 c4 = *(const f32x4*)(t + 4 * n), s4 = *(const f32x4*)(t + 32 + 4 * n); const f32x4 x1 = v[0][n], x2 = v[1][n];
                        v[0][n] = x1 * c4 - x2 * s4; v[1][n] = x1 * s4 + x2 * c4; }
                }
                bf16_t* rowp = base + (size_t)row * ld + col0;
#pragma unroll
                for (int bj = 0; bj < 2; ++bj) { const f32x4 v0 = v[bj][0] * osc, v1 = v[bj][1] * osc;
                    u32x4 o; o.x = pk2(v0[0], v0[1]); o.y = pk2(v0[2], v0[3]); o.z = pk2(v1[0], v1[1]); o.w = pk2(v1[2], v1[3]);
                    *(u32x4*)(rowp + 32 * bj) = o; }
            }
    }
};
struct EpiMlp1 {
    static constexpr bool PERM = true, AFTER_DRAIN = false;
    bf16_t* O; const float* rsq; const LAS float* rtab; mutable int ui;
    DI void operator()(const f32x4 (&acc)[2][2][4][2], const Unit& u, int wr, int wc, int fr, int fq) const {
        const int row0 = u.pm * BM + wr * 64 + fr; const int col0 = u.pn * BM + wc * 32 + 8 * fq; const int slot = ui++; const LAS float* rt = rtab + slot * 256 + wr * 64 + fr;
#pragma unroll
        for (int ai = 0; ai < 2; ++ai)
#pragma unroll
            for (int m = 0; m < 4; ++m) {
                const int row = row0 + ai * HALF + m * 16; const float ri = slot < RINV_SLOTS ? rt[ai * HALF + m * 16] : rowscale(rsq, row);
                bf16_t* rowp = O + (size_t)row * DFF + col0;
#pragma unroll
                for (int bj = 0; bj < 2; ++bj) { f32x4 v0 = acc[ai][bj][m][0] * ri, v1 = acc[ai][bj][m][1] * ri;
#pragma unroll
                    for (int j = 0; j < 4; ++j) { float a = fmaxf(v0[j], 0.f), b = fmaxf(v1[j], 0.f); v0[j] = a * a; v1[j] = b * b; }
                    u32x4 w; w.x = pk2(v0[0], v0[1]); w.y = pk2(v0[2], v0[3]); w.z = pk2(v1[0], v1[1]); w.w = pk2(v1[2], v1[3]);
                    *(u32x4*)(rowp + bj * HALF) = w; }
            }
    }
};
struct EpiP {
    static constexpr bool PERM = true, AFTER_DRAIN = false;
    bf16_t* O;
    DI void operator()(const f32x4 (&acc)[2][2][4][2], const Unit& u, int wr, int wc, int fr, int fq) const {
        const int row0 = u.pm * BM + wr * 64 + fr; const int col0 = u.pn * BM + wc * 32 + 8 * fq;
#pragma unroll
        for (int ai = 0; ai < 2; ++ai)
#pragma unroll
            for (int m = 0; m < 4; ++m) { bf16_t* rowp = O + (size_t)(row0 + ai * HALF + m * 16) * DM + col0;
#pragma unroll
                for (int bj = 0; bj < 2; ++bj) { const f32x4 v0 = acc[ai][bj][m][0], v1 = acc[ai][bj][m][1];
                    u32x4 w; w.x = pk2(v0[0], v0[1]); w.y = pk2(v0[2], v0[3]); w.z = pk2(v1[0], v1[1]); w.w = pk2(v1[2], v1[3]); *(u32x4*)(rowp + bj * HALF) = w; } }
    }
};
struct EpiResid {
    static constexpr bool PERM = true, AFTER_DRAIN = false;
    const float* xf; const bf16_t* xh; bf16_t* xb; float* rsq;
    DI void operator()(const f32x4 (&acc)[2][2][4][2], const Unit& u, int wr, int wc, int fr, int fq) const {
        const int row0 = u.pm * BM + wr * 64 + fr; const int col0 = u.pn * BM + wc * 32 + 8 * fq;
        if (xf) {
#pragma unroll
            for (int ai = 0; ai < 2; ++ai) { f32x4 xv[4][2][2];
#pragma unroll
                for (int m = 0; m < 4; ++m)
#pragma unroll
                    for (int bj = 0; bj < 2; ++bj) { const size_t o = (size_t)(row0 + ai * HALF + m * 16) * DM + col0 + bj * HALF; xv[m][bj][0] = *(const f32x4*)(xf + o); xv[m][bj][1] = *(const f32x4*)(xf + o + 4); }
                asm volatile("" ::: "memory");
#pragma unroll
                for (int m = 0; m < 4; ++m) { const int row = row0 + ai * HALF + m * 16; const size_t off = (size_t)row * DM + col0; float ss = 0.f;
#pragma unroll
                    for (int bj = 0; bj < 2; ++bj) { const size_t o = off + bj * HALF; const f32x4 v0 = xv[m][bj][0] + acc[ai][bj][m][0], v1 = xv[m][bj][1] + acc[ai][bj][m][1];
                        u32x4 w; w.x = pk2(v0[0], v0[1]); w.y = pk2(v0[2], v0[3]); w.z = pk2(v1[0], v1[1]); w.w = pk2(v1[2], v1[3]); *(u32x4*)(xb + o) = w;
                        ss += ((v0[0] * v0[0] + v0[1] * v0[1]) + (v0[2] * v0[2] + v0[3] * v0[3])) + ((v1[0] * v1[0] + v1[1] * v1[1]) + (v1[2] * v1[2] + v1[3] * v1[3])); }
                    if (rsq) { ss += __shfl_xor(ss, 16); ss += __shfl_xor(ss, 32); if (fq == 0) rsq[(size_t)row * 16 + u.pn * 4 + wc] = ss; } }
                asm volatile("" ::: "memory"); }
        } else {
            u32x4 hv[2][4][2];
#pragma unroll
            for (int ai = 0; ai < 2; ++ai)
#pragma unroll
                for (int m = 0; m < 4; ++m)
#pragma unroll
                    for (int bj = 0; bj < 2; ++bj) hv[ai][m][bj] = *(const u32x4*)(xh + (size_t)(row0 + ai * HALF + m * 16) * DM + col0 + bj * HALF);
            asm volatile("" ::: "memory");
#pragma unroll
            for (int ai = 0; ai < 2; ++ai)
#pragma unroll
                for (int m = 0; m < 4; ++m) { const int row = row0 + ai * HALF + m * 16; const size_t off = (size_t)row * DM + col0; float ss = 0.f;
#pragma unroll
                    for (int bj = 0; bj < 2; ++bj) { const size_t o = off + bj * HALF; const u32x4 h = hv[ai][m][bj];
                        const f32x4 v0 = (f32x4){bf_lo(h.x), bf_hi(h.x), bf_lo(h.y), bf_hi(h.y)} + acc[ai][bj][m][0], v1 = (f32x4){bf_lo(h.z), bf_hi(h.z), bf_lo(h.w), bf_hi(h.w)} + acc[ai][bj][m][1];
                        u32x4 w; w.x = pk2(v0[0], v0[1]); w.y = pk2(v0[2], v0[3]); w.z = pk2(v1[0], v1[1]); w.w = pk2(v1[2], v1[3]); *(u32x4*)(xb + o) = w;
                        ss += ((v0[0] * v0[0] + v0[1] * v0[1]) + (v0[2] * v0[2] + v0[3] * v0[3])) + ((v1[0] * v1[0] + v1[1] * v1[1]) + (v1[2] * v1[2] + v1[3] * v1[3])); }
                    if (rsq) { ss += __shfl_xor(ss, 16); ss += __shfl_xor(ss, 32); if (fq == 0) rsq[(size_t)row * 16 + u.pn * 4 + wc] = ss; } }
        }
    }
};
struct EpiGate {
    static constexpr bool PERM = true, AFTER_DRAIN = false;
    const bf16_t* xh; const bf16_t* P; bf16_t* xb; float* rsq; float* yout;
    DI void operator()(const f32x4 (&acc)[2][2][4][2], const Unit& u, int wr, int wc, int fr, int fq) const {
        const int row0 = u.pm * BM + wr * 64 + fr; const int col0 = u.pn * BM + wc * 32 + 8 * fq;
#pragma unroll
        for (int ai = 0; ai < 2; ++ai) {
            u32x4 pv[4][2], hv[4][2];
#pragma unroll
            for (int m = 0; m < 4; ++m)
#pragma unroll
                for (int bj = 0; bj < 2; ++bj) { const size_t o = (size_t)(row0 + ai * HALF + m * 16) * DM + col0 + bj * HALF; pv[m][bj] = *(const u32x4*)(P + o); hv[m][bj] = *(const u32x4*)(xh + o); }
            asm volatile("" ::: "memory");
#pragma unroll
            for (int m = 0; m < 4; ++m) { const int row = row0 + ai * HALF + m * 16; const size_t off = (size_t)row * DM + col0; float ss = 0.f;
#pragma unroll
                for (int bj = 0; bj < 2; ++bj) { const size_t o = off + bj * HALF; const f32x4 g0 = acc[ai][bj][m][0], g1 = acc[ai][bj][m][1]; const u32x4 pw = pv[m][bj]; const u32x4 h = hv[m][bj];
                    f32x4 v0 = (f32x4){bf_lo(h.x), bf_hi(h.x), bf_lo(h.y), bf_hi(h.y)}, v1 = (f32x4){bf_lo(h.z), bf_hi(h.z), bf_lo(h.w), bf_hi(h.w)};
                    v0[0] += bf_lo(pw.x) * __builtin_amdgcn_rcpf(1.f + __expf(-g0[0])); v0[1] += bf_hi(pw.x) * __builtin_amdgcn_rcpf(1.f + __expf(-g0[1]));
                    v0[2] += bf_lo(pw.y) * __builtin_amdgcn_rcpf(1.f + __expf(-g0[2])); v0[3] += bf_hi(pw.y) * __builtin_amdgcn_rcpf(1.f + __expf(-g0[3]));
                    v1[0] += bf_lo(pw.z) * __builtin_amdgcn_rcpf(1.f + __expf(-g1[0])); v1[1] += bf_hi(pw.z) * __builtin_amdgcn_rcpf(1.f + __expf(-g1[1]));
                    v1[2] += bf_lo(pw.w) * __builtin_amdgcn_rcpf(1.f + __expf(-g1[2])); v1[3] += bf_hi(pw.w) * __builtin_amdgcn_rcpf(1.f + __expf(-g1[3]));
                    if (yout) { *(f32x4*)(yout + o) = v0; *(f32x4*)(yout + o + 4) = v1; }
                    u32x4 w; w.x = pk2(v0[0], v0[1]); w.y = pk2(v0[2], v0[3]); w.z = pk2(v1[0], v1[1]); w.w = pk2(v1[2], v1[3]); *(u32x4*)(xb + o) = w;
                    ss += ((v0[0] * v0[0] + v0[1] * v0[1]) + (v0[2] * v0[2] + v0[3] * v0[3])) + ((v1[0] * v1[0] + v1[1] * v1[1]) + (v1[2] * v1[2] + v1[3] * v1[3])); }
                ss += __shfl_xor(ss, 16); ss += __shfl_xor(ss, 32); if (fq == 0) rsq[(size_t)row * 16 + u.pn * 4 + wc] = ss; }
            asm volatile("" ::: "memory");
        }
    }
};

DI void build_rinv(const pg8::StaticOrder& S, const float* rsq, LAS float* tab, int tid) {
    const int r = tid & 255;
#pragma unroll 1
    for (int i = tid >> 8; i < RINV_SLOTS; i += 2) { Unit u; if (!S.next(i, u)) break; tab[i * 256 + r] = rowscale(rsq, u.pm * BM + r); }
    __syncthreads();
}
#define XB_TMO      128
#define XB_XCNT(j)  (256  + 64 * (j))
#define XB_XSUB(j)  (1280 + 64 * (j))
#define XB_XGEN(j)  (2304 + 64 * (j))
#define XB_TOP      3328
#define XB_TOPGEN   3392
#define XCD_BAR_WORDS 3456
#define XB_SPIN_CAP (1u << 18)

__device__ __forceinline__ unsigned xb_ld(unsigned* p)              { return __hip_atomic_load(p, __ATOMIC_RELAXED, __HIP_MEMORY_SCOPE_AGENT); }
__device__ __forceinline__ unsigned xb_add(unsigned* p, unsigned v) { return __hip_atomic_fetch_add(p, v, __ATOMIC_RELAXED, __HIP_MEMORY_SCOPE_AGENT); }
__device__ __forceinline__ unsigned xb_xcc_id() { return (unsigned)__builtin_amdgcn_s_getreg((3 << 11) | 20) & 0xFu; }
#define XB_SPIN(cond, bar) do { unsigned _sp = 0; while (cond) { __builtin_amdgcn_s_sleep(1); \
    if ((++_sp & 255u) == 0u) { if (xb_ld(&(bar)[XB_TMO])) break; if (_sp > XB_SPIN_CAP) { atomicAdd(&(bar)[XB_TMO], 1u); break; } } } } while (0)

struct XcdBarrier {
    unsigned* bar; unsigned x;
    volatile LAS unsigned* st;
};

__device__ __forceinline__ XcdBarrier xcd_barrier_post(unsigned* bar, volatile LAS unsigned* st) {
    XcdBarrier b; b.bar = bar; b.x = xb_xcc_id(); b.st = st;
    if (threadIdx.x == 0) (void)xb_add(&bar[XB_XCNT(b.x)], 1u);
    return b;
}
__device__ __forceinline__ void xcd_barrier_complete(unsigned* bar, unsigned x, unsigned& nloc, unsigned& nx) {
    const unsigned G = gridDim.x * gridDim.y * gridDim.z;
    unsigned sum, cnt, mine, sp = 0u;
    for (;;) {
        sum = 0u; cnt = 0u; mine = 0u;
#pragma unroll
        for (unsigned j = 0; j < 16; ++j) { const unsigned c = xb_ld(&bar[XB_XCNT(j)]); sum += c; cnt += (c > 0u) ? 1u : 0u; mine = (j == x) ? c : mine; }
        if (sum == G) break;
        __builtin_amdgcn_s_sleep(1);
        if ((++sp & 255u) == 0u) { if (xb_ld(&bar[XB_TMO])) break; if (sp > XB_SPIN_CAP) { atomicAdd(&bar[XB_TMO], 1u); break; } }
    }
    nloc = mine > 0u ? mine : 1u; nx = cnt > 0u ? cnt : 1u;
}

__device__ __forceinline__ void xcd_barrier(const XcdBarrier& b, const int tid) {
    asm volatile("s_waitcnt vmcnt(0)" ::: "memory");
    __syncthreads();
    if (tid == 0) {
        unsigned* bar = b.bar;
        __builtin_amdgcn_s_waitcnt(0);
        unsigned nloc = b.st[0], nx = b.st[1];
        if (nloc == 0u) { xcd_barrier_complete(bar, b.x, nloc, nx); b.st[0] = nloc; b.st[1] = nx; }
        const unsigned old = xb_add(&bar[XB_XSUB(b.x)], 1u);
        const unsigned gen = old / nloc;
        if (old + 1u == (gen + 1u) * nloc) {
            __builtin_amdgcn_fence(__ATOMIC_RELEASE, "agent");
            asm volatile("s_waitcnt vmcnt(0)" ::: "memory");
            const unsigned og = xb_add(&bar[XB_TOP], 1u);
            const unsigned tg = og / nx;
            if (og + 1u == (tg + 1u) * nx) xb_add(&bar[XB_TOPGEN], 1u);
            else XB_SPIN(xb_ld(&bar[XB_TOPGEN]) == tg, bar);
            __builtin_amdgcn_fence(__ATOMIC_ACQUIRE, "agent");
            xb_add(&bar[XB_XGEN(b.x)], 1u);
            asm volatile("s_waitcnt vmcnt(0)" ::: "memory");
        } else {
            XB_SPIN(xb_ld(&bar[XB_XGEN(b.x)]) == gen, bar);
            __builtin_amdgcn_fence(__ATOMIC_ACQUIRE, "agent");
            asm volatile("s_waitcnt vmcnt(0)" ::: "memory");
        }
    }
    __syncthreads();
}

struct Grp { int NB, S, M, tok0; };
DI Grp grp_of(int g) { Grp G; if (g == 0) { G.NB = 2; G.S = 8192; G.M = 16384; G.tok0 = 0; } else { G.NB = 8; G.S = 4096; G.M = 32768; G.tok0 = 16384; } return G; }

DI int remap_in(int n) {
    const int blk = n >> 9, r = n & 511; const int ob = (blk == 0) ? 0 : (blk == 1) ? 3 : (blk == 2) ? 1 : (blk == 3) ? 2 : blk; return ob * 512 + r;
}
DI int win_src_col(int n) {
    const int pn = n >> 8, r = n & 255, bj = r >> 7, wc = (r >> 5) & 3, off = r & 31; int s = 32 * bj + off;
    if (pn == 0 || pn == 1 || pn == 4 || pn == 5) s = pi_diff(s);
    return remap_in(256 * pn + 64 * wc + s);
}
DI void transpose_item(const float* W, int K, int N, bf16_t* WT, const float* kscale, bool remap, LAS float* scr, int item, int lane) {
    const int nblk = N / 64, kb = item / nblk, nb = item % nblk, k0 = 64 * kb, n0 = 64 * nb; const int cg = lane & 15;
    const int scol = remap ? win_src_col(n0 + 4 * cg) : n0 + 4 * cg;
#pragma unroll 8
    for (int i = 0; i < 16; ++i) { const int kk = 4 * i + (lane >> 4); f32x4 v = *(const f32x4*)(W + (size_t)(k0 + kk) * N + scol); if (kscale) v = v * kscale[k0 + kk];
        LAS float* d = scr + kk * 65 + 4 * cg; d[0] = v[0]; d[1] = v[1]; d[2] = v[2]; d[3] = v[3]; }
    asm volatile("s_waitcnt lgkmcnt(0)" ::: "memory");
    const int c = lane & 7;
#pragma unroll
    for (int j = 0; j < 8; ++j) { const int n = (lane >> 3) + 8 * j; const LAS float* s = scr + (8 * c) * 65 + n;
        u32x4 o; o.x = pk2(s[0 * 65], s[1 * 65]); o.y = pk2(s[2 * 65], s[3 * 65]); o.z = pk2(s[4 * 65], s[5 * 65]); o.w = pk2(s[6 * 65], s[7 * 65]);
        *(u32x4*)(WT + (size_t)(n0 + n) * K + k0 + 8 * c) = o; }
    asm volatile("s_waitcnt lgkmcnt(0)" ::: "memory");
}
DI void phase_weights(const Params& p, LAS unsigned char* lds, int gw, int NGW, int wave, int lane) {
    LAS float* scr = (LAS float*)(lds + wave * 16896);
    constexpr int I_IN = (DM / 64) * (NIN / 64), I_OUT = (DM / 64) * (DM / 64), I_1 = (DM / 64) * (DFF / 64), I_2 = (DFF / 64) * (DM / 64), I_G = I_OUT, I_P = (PLE / 64) * (DM / 64);
    constexpr int PER_L = I_IN + I_OUT + I_1 + I_2 + I_G + I_P;
    for (int it = gw; it < PER_L * DEPTH; it += NGW) {
        const int L = it / PER_L; int r = it % PER_L;
        bf16_t* wt = (bf16_t*)(p.ws + OFF_WT) + (size_t)L * WL_SIZE;
        if (r < I_IN) { transpose_item(p.w_in + (size_t)L * DM * NIN, DM, NIN, wt + WL_IN, p.ln1 + L * DM, true, scr, r, lane); continue; } r -= I_IN;
        if (r < I_OUT) { transpose_item(p.w_out + (size_t)L * DM * DM, DM, DM, wt + WL_OUT, nullptr, false, scr, r, lane); continue; } r -= I_OUT;
        if (r < I_1) { transpose_item(p.w1 + (size_t)L * DM * DFF, DM, DFF, wt + WL_1, p.ln2 + L * DM, false, scr, r, lane); continue; } r -= I_1;
        if (r < I_2) { transpose_item(p.w2 + (size_t)L * DFF * DM, DFF, DM, wt + WL_2, nullptr, false, scr, r, lane); continue; } r -= I_2;
        if (r < I_G) { transpose_item(p.wg + (size_t)L * DM * DM, DM, DM, wt + WL_G, nullptr, false, scr, r, lane); continue; } r -= I_G;
        transpose_item(p.wp + (size_t)L * PLE * DM, PLE, DM, wt + WL_P, nullptr, false, scr, r, lane);
    }
}
DI void phase_prep_x(const float* x, bf16_t* xb, float* rsq, int M, int gw, int NGW, int lane) {
    for (int m = gw; m < M; m += NGW) {
        const f32x4* xr = (const f32x4*)(x + (size_t)m * DM) + lane; u32x2* o = (u32x2*)(xb + (size_t)m * DM) + lane; float s = 0.f;
#pragma unroll
        for (int j = 0; j < 4; ++j) { const f32x4 v = xr[64 * j]; s += (v.x * v.x + v.y * v.y) + (v.z * v.z + v.w * v.w); u32x2 w; w.x = pk2(v.x, v.y); w.y = pk2(v.z, v.w); o[64 * j] = w; }
        s = wave_sum(s);
        if (lane < 16) rsq[(size_t)m * 16 + lane] = (lane == 0) ? s : 0.f;
    }
}
DI void sincos_rev(float ang, float& s, float& c) {
    double rev = (double)ang * 0.15915494309189535; rev -= __builtin_rint(rev); const float fr = (float)rev;
    s = __builtin_amdgcn_sinf(fr); c = __builtin_amdgcn_cosf(fr);
}
DI void phase_trig(const Params& p, int gthread, int nthreads) {
    float* tr = (float*)(p.ws + OFF_TRIGR); float* td = (float*)(p.ws + OFF_TRIGD);
    for (int i = gthread; i < 8192 * 40; i += nthreads) { const int pos = i / 40, f = i % 40; float sn, cs;
        if (f < 32) { sincos_rev((float)pos * ROT_R[f], sn, cs); tr[(size_t)pos * 64 + f] = cs; tr[(size_t)pos * 64 + 32 + f] = sn; }
        else { sincos_rev((float)pos * ROT_D[f - 32], sn, cs); td[(size_t)pos * 16 + (f - 32)] = cs; td[(size_t)pos * 16 + 8 + (f - 32)] = sn; } }
}
DI void phase_pb(const Params& p, const Grp& G, int layer, int g, int gw, int NGW, int lane) {
    bf16_t* pb = (bf16_t*)(p.ws + OFF_PB); const float* pin = (g ? p.p_in[1] : p.p_in[0]) + (size_t)layer * G.M * PLE;
    for (int m0 = gw; m0 < G.M; m0 += 4 * NGW) {
        f32x4 v[4];
#pragma unroll
        for (int k = 0; k < 4; ++k) v[k] = *((const f32x4*)(pin + (size_t)(m0 + k * NGW) * PLE) + lane);
        asm volatile("" ::: "memory");
#pragma unroll
        for (int k = 0; k < 4; ++k) { u32x2 w; w.x = pk2(v[k].x, v[k].y); w.y = pk2(v[k].z, v[k].w); *((u32x2*)(pb + (size_t)(m0 + k * NGW) * PLE) + lane) = w; }
    }
}
DI void rot_token(const Params& p, int layer, float pos, int l8, const float (&qw)[8], const float (&kw)[8], const u32x4 (&win)[4], u32x4 (&wout)[4]) {
    float cd[8], sd[8];
    if (l8 < 2) {
#pragma unroll
        for (int e = 0; e < 8; ++e) sincos_rev(pos * ROT_D[e], sd[e], cd[e]);
    } else {
#pragma unroll
        for (int e = 0; e < 8; ++e) { sd[e] = 0.f; cd[e] = 1.f; }
    }
#pragma unroll
    for (int which = 0; which < 2; ++which) {
        const u32x4 w = win[which]; float v[8] = {bf_lo(w.x), bf_hi(w.x), bf_lo(w.y), bf_hi(w.y), bf_lo(w.z), bf_hi(w.z), bf_lo(w.w), bf_hi(w.w)};
        float ss = 0.f;
#pragma unroll
        for (int e = 0; e < 8; ++e) ss += v[e] * v[e];
        ss += __shfl_xor(ss, 1); ss += __shfl_xor(ss, 2); ss += __shfl_xor(ss, 4);
        const float ri = rsqrtf(ss * (1.0f / 64.0f) + EPSN);
#pragma unroll
        for (int e = 0; e < 8; ++e) v[e] = v[e] * ri * (which == 0 ? qw[e] : kw[e]);
        float o[8];
#pragma unroll
        for (int e = 0; e < 8; ++e) { const float pr = __shfl_xor(v[e], 1);
            o[e] = (l8 == 0) ? (v[e] * cd[e] - pr * sd[e]) : (l8 == 1) ? (pr * sd[e] + v[e] * cd[e]) : v[e]; }
        const float sc = which == 0 ? (0.125f * LOG2E) : 1.0f;
        u32x4 r; r.x = pk2(o[0] * sc, o[1] * sc); r.y = pk2(o[2] * sc, o[3] * sc); r.z = pk2(o[4] * sc, o[5] * sc); r.w = pk2(o[6] * sc, o[7] * sc);
        wout[which] = r;
    }
    float cr[8], sr[8];
#pragma unroll
    for (int e = 0; e < 8; ++e) sincos_rev(pos * ROT_R[(l8 & 3) * 8 + e], sr[e], cr[e]);
#pragma unroll
    for (int which = 0; which < 2; ++which) {
        const u32x4 w = win[2 + which]; float v[8] = {bf_lo(w.x), bf_hi(w.x), bf_lo(w.y), bf_hi(w.y), bf_lo(w.z), bf_hi(w.z), bf_lo(w.w), bf_hi(w.w)};
        float o[8];
#pragma unroll
        for (int e = 0; e < 8; ++e) { const float pr = __shfl_xor(v[e], 4);
            o[e] = (l8 < 4) ? (v[e] * cr[e] - pr * sr[e]) : (pr * sr[e] + v[e] * cr[e]); }
        const float sc = which == 0 ? 1.0f : 0.125f;
        u32x4 r; r.x = pk2(o[0] * sc, o[1] * sc); r.y = pk2(o[2] * sc, o[3] * sc); r.z = pk2(o[4] * sc, o[5] * sc); r.w = pk2(o[6] * sc, o[7] * sc);
        wout[2 + which] = r;
    }
}
DI void phase_rot(const Params& p, const Grp& G, int layer, int g, int gw, int NGW, int lane, bool dry) {
    bf16_t* mix = (bf16_t*)(p.ws + OFF_BIG + BIG_MIX); bf16_t* rest = (bf16_t*)(p.ws + OFF_BIG + BIG_REST); bf16_t* pb = (bf16_t*)(p.ws + OFF_PB);
    bf16_t* omix = dry ? (bf16_t*)(p.ws + OFF_DUMMY) : mix; bf16_t* orest = dry ? (bf16_t*)(p.ws + OFF_DUMMY) : rest; const size_t omask = dry ? 63 : ~(size_t)0;
    const float* pin = (g ? p.p_in[1] : p.p_in[0]) + (size_t)layer * G.M * PLE;
    const int l8 = lane & 7, d0 = l8 * 8;
    float qw[8], kw[8];
#pragma unroll
    for (int e = 0; e < 8; ++e) { qw[e] = p.qn[layer * 64 + d0 + e]; kw[e] = p.kn[layer * 64 + d0 + e]; }
    for (int m0 = gw; m0 < G.M; m0 += 2 * NGW) {
        u32x4 win[2][4], wout[2][4]; f32x4 pv[2];
#pragma unroll
        for (int t = 0; t < 2; ++t) { const size_t m = (size_t)m0 + (size_t)t * NGW;
            win[t][0] = *(const u32x4*)(mix + m * MIXW + lane * 8); win[t][1] = *(const u32x4*)(rest + m * RESTW + R_DK + lane * 8);
            win[t][2] = *(const u32x4*)(mix + m * MIXW + 512 + lane * 8); win[t][3] = *(const u32x4*)(rest + m * RESTW + R_RK + lane * 8);
            pv[t] = *((const f32x4*)(pin + m * PLE) + lane); }
#pragma unroll
        for (int t = 0; t < 2; ++t) { const size_t m = (size_t)m0 + (size_t)t * NGW;
            rot_token(p, layer, (float)((int)m % G.S), l8, qw, kw, win[t], wout[t]);
            const size_t mo = m & omask;
            *(u32x4*)(omix + mo * MIXW + lane * 8) = wout[t][0]; *(u32x4*)(orest + mo * RESTW + R_DK + lane * 8) = wout[t][1];
            *(u32x4*)(omix + mo * MIXW + 512 + lane * 8) = wout[t][2]; *(u32x4*)(orest + mo * RESTW + R_RK + lane * 8) = wout[t][3];
            u32x2 w; w.x = pk2(pv[t].x, pv[t].y); w.y = pk2(pv[t].z, pv[t].w); *((u32x2*)(pb + m * PLE) + lane) = w; }
    }
}
DI float log2_gamma(const float* decay, int layer, int dir, int head) {
    const float xl = decay[layer * 16 + dir * 8 + head]; return -log1pf(expf(-xl)) * LOG2E;
}
constexpr int RP = 272;
DI void phase_ret_kv(const Params& p, const Grp& G, int layer, LAS unsigned char* lds, int tid, int wave, int lane) {
    const bf16_t* rest = (const bf16_t*)(p.ws + OFF_BIG + BIG_REST); bf16_t* ST = (bf16_t*)(p.ws + OFF_ST16);
    const int NC = G.S / 128, nunits = G.NB * NC * 4;
    LAS unsigned char* Kt = lds; LAS unsigned char* Vf = lds + 128 * RP; LAS unsigned char* Vb = lds + 2 * 128 * RP;
    const int hh = wave >> 2, ti = (wave >> 1) & 1, tj = wave & 1, hi = lane >> 5, q4 = (lane & 15) >> 2, p4 = lane & 3, blk = (lane >> 4) & 1;
    u32x4 pk[4], pv[4];
#define R1_ISSUE(u_) do { const int hp_ = (u_) & 3, c_ = ((u_) >> 2) % NC, b_ = ((u_) >> 2) / NC; const size_t r0_ = (size_t)b_ * G.S + (size_t)c_ * 128; \
        int tv_ = tid; asm volatile("" : "+v"(tv_)); \
        _Pragma("unroll") for (int i = 0; i < 4; ++i) { const int q = tv_ + 512 * i, row = q >> 4, ch = q & 15; const bf16_t* src = rest + (r0_ + row) * RESTW + hp_ * 128 + ch * 8; \
            pk[i] = *(const u32x4*)(src + R_RK); pv[i] = *(const u32x4*)(src + R_RV); } } while (0)
    if ((int)blockIdx.x < nunits) R1_ISSUE((int)blockIdx.x);
    for (int u = blockIdx.x; u < nunits; u += gridDim.x) {
        const int hp = u & 3, c = (u >> 2) % NC, b = (u >> 2) / NC;
        const float lgf_s = log2_gamma(p.decay, layer, 0, 2 * hp + ((tid & 15) >> 3)), lgb_s = log2_gamma(p.decay, layer, 1, 2 * hp + ((tid & 15) >> 3));
        __syncthreads();
#pragma unroll
        for (int i = 0; i < 4; ++i) { const int q = tid + 512 * i, row = q >> 4, ch = q & 15;
            const u32x4 kv = pk[i]; const u32x4 vv = pv[i];
            *(LAS u32x4*)(Kt + row * RP + ch * 16) = kv;
            const float df = __builtin_amdgcn_exp2f(lgf_s * (float)(127 - row)), db = __builtin_amdgcn_exp2f(lgb_s * (float)row);
            u32x4 a, bb;
            a.x = pk2(bf_lo(vv.x) * df, bf_hi(vv.x) * df); a.y = pk2(bf_lo(vv.y) * df, bf_hi(vv.y) * df); a.z = pk2(bf_lo(vv.z) * df, bf_hi(vv.z) * df); a.w = pk2(bf_lo(vv.w) * df, bf_hi(vv.w) * df);
            bb.x = pk2(bf_lo(vv.x) * db, bf_hi(vv.x) * db); bb.y = pk2(bf_lo(vv.y) * db, bf_hi(vv.y) * db); bb.z = pk2(bf_lo(vv.z) * db, bf_hi(vv.z) * db); bb.w = pk2(bf_lo(vv.w) * db, bf_hi(vv.w) * db);
            *(LAS u32x4*)(Vf + row * RP + ch * 16) = a; *(LAS u32x4*)(Vb + row * RP + ch * 16) = bb; }
        if (u + (int)gridDim.x < nunits) R1_ISSUE(u + (int)gridDim.x);
        __syncthreads();
        f32x16 af = {}, ab = {};
#pragma unroll
        for (int s = 0; s < 8; ++s) {
            const int rowa = (16 * s + 8 * hi + q4) * RP;
            const int cola = (hh * 64 + 32 * ti + 16 * blk + 4 * p4) * 2, colb = (hh * 64 + 32 * tj + 16 * blk + 4 * p4) * 2;
            const bf16x8 A = cat8(vtr(Kt + rowa + cola), vtr(Kt + rowa + 4 * RP + cola));
            const bf16x8 Bf = cat8(vtr(Vf + rowa + colb), vtr(Vf + rowa + 4 * RP + colb));
            const bf16x8 Bb = cat8(vtr(Vb + rowa + colb), vtr(Vb + rowa + 4 * RP + colb));
            af = MFMA32(A, Bf, af); ab = MFMA32(A, Bb, ab);
        }
        __syncthreads();
        { LAS bf16_t* img = (LAS bf16_t*)lds + hh * 8192;
#pragma unroll
          for (int r = 0; r < 16; ++r) { const int i = 32 * ti + crow(r, hi), j = 32 * tj + (lane & 31); img[i * 64 + j] = f2bf1(af[r]); img[4096 + i * 64 + j] = f2bf1(ab[r]); } }
        __syncthreads();
#pragma unroll
        for (int i = 0; i < 4; ++i) { const int q = tid + 512 * i, h2 = q >> 10, w = q & 1023;
            *(u32x4*)(ST + ((size_t)((b * 8 + 2 * hp + h2) * NC + c) * 2) * 4096 + w * 8) = *(const LAS u32x4*)((LAS bf16_t*)lds + h2 * 8192 + w * 8); }
    }
#undef R1_ISSUE
}
DI void phase_ret_scan(const Params& p, const Grp& G, int layer, int tid, bool dry) {
    bf16_t* S16 = (bf16_t*)(p.ws + OFF_ST16); const int NC = G.S / 128; const int total = G.NB * 8 * 2 * 512;
    for (int t = blockIdx.x * NTHREADS + tid; t < total; t += gridDim.x * NTHREADS) {
        const int e = (t & 511) * 8, dir = (t >> 9) & 1, bh = t >> 10, head = bh & 7;
        const float cd = __builtin_amdgcn_exp2f(log2_gamma(p.decay, layer, dir, head) * 128.0f);
        bf16_t* base = S16 + ((size_t)bh * NC * 2 + dir) * 4096 + e; float run[8];
#pragma unroll
        for (int k = 0; k < 8; ++k) run[k] = 0.f;
#define SCAN_STEP(idx_) do { const u32x4 kv_ = kvv[idx_]; u32x4 w_; w_.x = pk2(run[0], run[1]); w_.y = pk2(run[2], run[3]); w_.z = pk2(run[4], run[5]); w_.w = pk2(run[6], run[7]); \
            *(u32x4*)(base + (size_t)(c0 + (idx_)) * 8192) = w_; \
            run[0] = run[0] * cd + bf_lo(kv_.x); run[1] = run[1] * cd + bf_hi(kv_.x); run[2] = run[2] * cd + bf_lo(kv_.y); run[3] = run[3] * cd + bf_hi(kv_.y); \
            run[4] = run[4] * cd + bf_lo(kv_.z); run[5] = run[5] * cd + bf_hi(kv_.z); run[6] = run[6] * cd + bf_lo(kv_.w); run[7] = run[7] * cd + bf_hi(kv_.w); } while (0)
        if (dir == 0) {
            for (int c0 = 0; c0 < NC; c0 += 16) { u32x4 kvv[16];
#pragma unroll
                for (int i = 0; i < 16; ++i) kvv[i] = *(const u32x4*)(base + (size_t)(c0 + i) * 8192);
                asm volatile("" ::: "memory");
#pragma unroll
                for (int i = 0; i < 16; ++i) SCAN_STEP(i); }
        } else {
            for (int c0 = NC - 16; c0 >= 0; c0 -= 16) { u32x4 kvv[16];
#pragma unroll
                for (int i = 0; i < 16; ++i) kvv[i] = *(const u32x4*)(base + (size_t)(c0 + i) * 8192);
                asm volatile("" ::: "memory");
#pragma unroll
                for (int i = 15; i >= 0; --i) SCAN_STEP(i); }
        }
#undef SCAN_STEP
    }
}
constexpr int R3_S = 2 * 128 * RP;
DI void phase_ret_out(const Params& p, const Grp& G, int layer, LAS unsigned char* lds, int tid, int wave, int lane, bool dry) {
    bf16_t* mix = (bf16_t*)(p.ws + OFF_BIG + BIG_MIX); const bf16_t* rest = (const bf16_t*)(p.ws + OFF_BIG + BIG_REST); const bf16_t* ST = (const bf16_t*)(p.ws + OFF_ST16);
    const int NC = G.S / 128, nunits = G.NB * NC * 4;
    LAS unsigned char* Kt = lds; LAS unsigned char* Vt = lds + 128 * RP; LAS bf16_t* Sl = (LAS bf16_t*)(lds + R3_S);
    const int hh = wave >> 2, qg = wave & 3, hi = lane >> 5, l31 = lane & 31, q4 = (lane & 15) >> 2, p4 = lane & 3, blk = (lane >> 4) & 1;
    u32x4 pk[4], pv[4], ps[4];
#define R3_ISSUE(u_) do { const int hp_ = (u_) & 3, c_ = ((u_) >> 2) % NC, b_ = ((u_) >> 2) / NC; const size_t r0_ = (size_t)b_ * G.S + (size_t)c_ * 128; \
        int tv_ = tid; asm volatile("" : "+v"(tv_)); \
        _Pragma("unroll") for (int i = 0; i < 4; ++i) { const int q = tv_ + 512 * i, row = q >> 4, ch = q & 15; const bf16_t* src = rest + (r0_ + row) * RESTW + hp_ * 128 + ch * 8; \
            pk[i] = *(const u32x4*)(src + R_RK); pv[i] = *(const u32x4*)(src + R_RV); } \
        _Pragma("unroll") for (int i = 0; i < 4; ++i) { const int q = tv_ + 512 * i, h2 = q >> 10, w = q & 1023; \
            ps[i] = *(const u32x4*)(ST + ((size_t)((b_ * 8 + 2 * hp_ + h2) * NC + c_) * 2) * 4096 + w * 8); } } while (0)
    if ((int)blockIdx.x < nunits) R3_ISSUE((int)blockIdx.x);
    for (int u = blockIdx.x; u < nunits; u += gridDim.x) {
        const int hp = u & 3, c = (u >> 2) % NC, b = (u >> 2) / NC; const size_t row0 = (size_t)b * G.S + (size_t)c * 128; const int head = 2 * hp + hh;
        __syncthreads();
        int tidv = tid; asm volatile("" : "+v"(tidv));
#pragma unroll
        for (int i = 0; i < 4; ++i) { const int q = tidv + 512 * i, row = q >> 4, ch = q & 15;
            *(LAS u32x4*)(Kt + row * RP + ch * 16) = pk[i]; *(LAS u32x4*)(Vt + row * RP + ch * 16) = pv[i]; }
#pragma unroll
        for (int i = 0; i < 4; ++i) { const int q = tidv + 512 * i, h2 = q >> 10, w = q & 1023; *(LAS u32x4*)(Sl + h2 * 8192 + w * 8) = ps[i]; }
        bf16x8 qf[4];
        { const bf16_t* qp = mix + (row0 + 32 * qg + l31) * MIXW + 512 + head * 64 + 8 * hi;
#pragma unroll
          for (int d0 = 0; d0 < 4; ++d0) qf[d0] = *(const bf16x8*)(qp + 16 * d0); }
        u32x4 gwv[4];
        { int lv0 = lane; asm volatile("" : "+v"(lv0)); const bf16_t* gb0 = rest + (row0 + 32 * qg) * RESTW + R_RG + head * 64;
#pragma unroll
          for (int i = 0; i < 4; ++i) { const int q = lv0 + 64 * i; gwv[i] = *(const u32x4*)(gb0 + (size_t)(q >> 3) * RESTW + (q & 7) * 8); } }
        if (u + (int)gridDim.x < nunits) R3_ISSUE(u + (int)gridDim.x);
        const float lgf = log2_gamma(p.decay, layer, 0, head), lgb = log2_gamma(p.decay, layer, 1, head);
        __syncthreads();
        f32x16 o[2]; o[0] = f32x16{}; o[1] = f32x16{};
        const int nl = 32 * qg + l31;
#pragma unroll 1
        for (int rb = 0; rb < 4; ++rb) {
            f32x16 sacc = {};
#pragma unroll
            for (int d0 = 0; d0 < 4; ++d0) { const bf16x8 A = *(const LAS bf16x8*)(Kt + (32 * rb + l31) * RP + (hh * 64 + 16 * d0 + 8 * hi) * 2); sacc = MFMA32(A, qf[d0], sacc); }
#pragma unroll
            for (int r = 0; r < 16; ++r) { const int mloc = 32 * rb + crow(r, hi); const int df = nl - mloc; const float D = df >= 0 ? __builtin_amdgcn_exp2f(lgf * (float)df) : __builtin_amdgcn_exp2f(lgb * (float)(-df)); sacc[r] *= D; }
#pragma unroll
            for (int s2 = 0; s2 < 2; ++s2) { const bf16x8 A = pack8(sacc, s2); const int rowa = (32 * rb + 16 * s2 + 4 * hi + q4) * RP;
#pragma unroll
                for (int cb = 0; cb < 2; ++cb) { const int colb = (hh * 64 + 32 * cb + 16 * blk + 4 * p4) * 2;
                    const bf16x8 B = cat8(vtr(Vt + rowa + colb), vtr(Vt + rowa + 8 * RP + colb)); o[cb] = MFMA32(A, B, o[cb]); } }
        }
#pragma unroll 1
        for (int dir = 0; dir < 2; ++dir) {
            const LAS bf16_t* S = Sl + (hh * 2 + dir) * 4096; f32x16 t[2]; t[0] = f32x16{}; t[1] = f32x16{};
#pragma unroll
            for (int ks = 0; ks < 4; ++ks) {
#pragma unroll
                for (int cb = 0; cb < 2; ++cb) { const LAS bf16_t* sp = S + (16 * ks + 8 * hi) * 64 + 32 * cb + l31;
                    u32x4 w; w.x = (unsigned)sp[0] | ((unsigned)sp[64] << 16); w.y = (unsigned)sp[128] | ((unsigned)sp[192] << 16); w.z = (unsigned)sp[256] | ((unsigned)sp[320] << 16); w.w = (unsigned)sp[384] | ((unsigned)sp[448] << 16);
                    t[cb] = MFMA32(qf[ks], __builtin_bit_cast(bf16x8, w), t[cb]); }
                asm volatile("" ::: "memory"); }
#pragma unroll
            for (int r = 0; r < 16; ++r) { const int nrow = 32 * qg + crow(r, hi); const float sc = dir == 0 ? __builtin_amdgcn_exp2f(lgf * (float)(nrow + 1)) : __builtin_amdgcn_exp2f(lgb * (float)(128 - nrow));
                o[0][r] += t[0][r] * sc; o[1][r] += t[1][r] * sc; }
        }
        const float g0 = p.gn[layer * 64 + l31], g1 = p.gn[layer * 64 + 32 + l31];
        __syncthreads();
        LAS float* stg = (LAS float*)(lds + wave * 8192);
#pragma unroll
        for (int r = 0; r < 16; ++r) {
            float ss = o[0][r] * o[0][r] + o[1][r] * o[1][r]; ss = half_sum32(ss); const float ri = rsqrtf(ss * (1.0f / 64.0f) + EPSN);
            LAS float* sp = stg + crow(r, hi) * 64 + l31; sp[0] = o[0][r] * ri * g0; sp[32] = o[1][r] * ri * g1;
        }
        asm volatile("s_waitcnt lgkmcnt(0)" ::: "memory");
        { int lv = lane; asm volatile("" : "+v"(lv));
          bf16_t* ob = (dry ? (bf16_t*)(p.ws + OFF_DUMMY) : mix + row0 * MIXW) + (size_t)(32 * qg) * MIXW + 512 + head * 64; const bf16_t* gb = rest + (row0 + 32 * qg) * RESTW + R_RG + head * 64;
#pragma unroll
          for (int i = 0; i < 4; ++i) { const int q = lv + 64 * i, row = q >> 3, ch = q & 7;
            const f32x4 a0 = *(const LAS f32x4*)(stg + row * 64 + ch * 8), a1 = *(const LAS f32x4*)(stg + row * 64 + ch * 8 + 4);
            const u32x4 gw = gwv[i];
            float gv[8] = {bf_lo(gw.x), bf_hi(gw.x), bf_lo(gw.y), bf_hi(gw.y), bf_lo(gw.z), bf_hi(gw.z), bf_lo(gw.w), bf_hi(gw.w)}; float ov[8];
#pragma unroll
            for (int e = 0; e < 8; ++e) ov[e] = (e < 4 ? a0[e & 3] : a1[e & 3]) * (gv[e] * __builtin_amdgcn_rcpf(1.f + __expf(-gv[e])));
            u32x4 w; w.x = pk2(ov[0], ov[1]); w.y = pk2(ov[2], ov[3]); w.z = pk2(ov[4], ov[5]); w.w = pk2(ov[6], ov[7]);
            *(u32x4*)(ob + (size_t)row * MIXW + ch * 8) = w; } }
    }
#undef R3_ISSUE
}
constexpr int VP = 320;
constexpr int ATT_BUF = 64 * RP + 64 * VP;
constexpr int ATT_LSCR = 2 * ATT_BUF;
DI void phase_attn(const Params& p, const Grp& G, int layer, LAS unsigned char* lds, int tid, int wave, int lane, int vcu, bool dry) {
    bf16_t* mix = (bf16_t*)(p.ws + OFF_BIG + BIG_MIX); const bf16_t* rest = (const bf16_t*)(p.ws + OFF_BIG + BIG_REST);
    const int NQB = G.S / 128, nunits = G.NB * 4 * NQB, NT = G.S / 64;
    const int c = wave >> 2, qg = wave & 3, hi = lane >> 5, l31 = lane & 31, q4 = (lane & 15) >> 2, p4 = lane & 3, blk = (lane >> 4) & 1;
    float lamv, bound2;
    { const float* lp = p.lam + layer * 256; const float s1 = wave_sum(lp[lane] * lp[64 + lane]), s2 = wave_sum(lp[128 + lane] * lp[192 + lane]);
      const float lam_init = 0.8f - 0.6f * expf(-0.3f * (float)layer); lamv = expf(s1) - expf(s2) + lam_init;
      const float mq = wave_max(fabsf(p.qn[layer * 64 + lane])), mk = wave_max(fabsf(p.kn[layer * 64 + lane])); bound2 = 8.0f * mq * mk * LOG2E; }
    const float lam_init = 0.8f - 0.6f * expf(-0.3f * (float)layer);
    LAS float* lscr = (LAS float*)(lds + ATT_LSCR) + wave * 32;
    const int lrow = tid >> 4, lch = tid & 15;
    for (int u = vcu; u < nunits; u += gridDim.x) {
        const int qb = u % NQB, bh = u / NQB, h = bh & 3, b = bh >> 2; const size_t seq0 = (size_t)b * G.S; const size_t qrow0 = seq0 + (size_t)qb * 128;
        bf16x8 qf[4];
        { const bf16_t* qp = mix + (qrow0 + 32 * qg + l31) * MIXW + h * 128 + c * 64 + 8 * hi;
#pragma unroll
          for (int d0 = 0; d0 < 4; ++d0) qf[d0] = *(const bf16x8*)(qp + 16 * d0); }
        const bf16_t* kbase = rest + (seq0 + lrow) * RESTW + R_DK + h * 128 + lch * 8; const bf16_t* vbase = rest + (seq0 + lrow) * RESTW + R_DV + h * 128 + lch * 8;
        u32x4 gk0, gk1, gv0, gv1;
        gk0 = *(const u32x4*)kbase; gk1 = *(const u32x4*)(kbase + (size_t)32 * RESTW); gv0 = *(const u32x4*)vbase; gv1 = *(const u32x4*)(vbase + (size_t)32 * RESTW);
        __syncthreads();
        { LAS unsigned char* Kt = lds; LAS unsigned char* Vt = lds + 64 * RP;
          *(LAS u32x4*)(Kt + lrow * RP + lch * 16) = gk0; *(LAS u32x4*)(Kt + (lrow + 32) * RP + lch * 16) = gk1;
          *(LAS u32x4*)(Vt + lrow * VP + lch * 16) = gv0; *(LAS u32x4*)(Vt + (lrow + 32) * VP + lch * 16) = gv1; }
        __syncthreads();
        f32x16 o[4]; o[0] = f32x16{}; o[1] = f32x16{}; o[2] = f32x16{}; o[3] = f32x16{};
        float lsum = 0.f;
        for (int t = 0; t < NT; ++t) {
            if (t + 1 < NT) { const size_t adv = (size_t)(t + 1) * 64 * RESTW;
                gk0 = *(const u32x4*)(kbase + adv); gk1 = *(const u32x4*)(kbase + adv + (size_t)32 * RESTW); gv0 = *(const u32x4*)(vbase + adv); gv1 = *(const u32x4*)(vbase + adv + (size_t)32 * RESTW); }
            LAS unsigned char* Kt = lds + (t & 1) * ATT_BUF; LAS unsigned char* Vt = Kt + 64 * RP;
            bf16x8 pa[4];
#pragma unroll
            for (int rb = 0; rb < 2; ++rb) {
                f32x16 s = {};
#pragma unroll
                for (int d0 = 0; d0 < 4; ++d0) { const bf16x8 A = *(const LAS bf16x8*)(Kt + (32 * rb + l31) * RP + (c * 64 + 16 * d0 + 8 * hi) * 2); s = MFMA32(A, qf[d0], s); }
                float ps = 0.f;
#pragma unroll
                for (int r = 0; r < 16; ++r) { s[r] = __builtin_amdgcn_exp2f(s[r] - bound2); ps += s[r]; }
                lsum += ps;
                pa[2 * rb] = pack8(s, 0); pa[2 * rb + 1] = pack8(s, 1);
            }
#pragma unroll
            for (int ks = 0; ks < 4; ++ks) { const int rowa = (16 * ks + 4 * hi + q4) * VP;
#pragma unroll
                for (int cb = 0; cb < 4; ++cb) { const int colb = (32 * cb + 16 * blk + 4 * p4) * 2;
                    const bf16x8 B = cat8(vtr(Vt + rowa + colb), vtr(Vt + rowa + 8 * VP + colb)); o[cb] = MFMA32(pa[ks], B, o[cb]); } }
            if (t + 1 < NT) { LAS unsigned char* Kn = lds + ((t + 1) & 1) * ATT_BUF; LAS unsigned char* Vn = Kn + 64 * RP;
                *(LAS u32x4*)(Kn + lrow * RP + lch * 16) = gk0; *(LAS u32x4*)(Kn + (lrow + 32) * RP + lch * 16) = gk1;
                *(LAS u32x4*)(Vn + lrow * VP + lch * 16) = gv0; *(LAS u32x4*)(Vn + (lrow + 32) * VP + lch * 16) = gv1; }
            __syncthreads();
        }
        lsum += __shfl_xor(lsum, 32);
        if (hi == 0) lscr[l31] = lsum;
        __syncthreads();
        float rl[16];
#pragma unroll
        for (int r = 0; r < 16; ++r) rl[r] = __builtin_amdgcn_rcpf(lscr[crow(r, hi)]);
#pragma unroll
        for (int cb = 0; cb < 4; ++cb)
#pragma unroll
            for (int r = 0; r < 16; ++r) o[cb][r] *= rl[r];
        LAS float* ex = (LAS float*)lds + qg * 4096;
        if (c == 1) {
#pragma unroll
            for (int cb = 0; cb < 4; ++cb)
#pragma unroll
                for (int r = 0; r < 16; ++r) ex[crow(r, hi) * 128 + 32 * cb + l31] = o[cb][r];
        }
        __syncthreads();
        if (c == 0) {
            bf16_t* obase = dry ? (bf16_t*)(p.ws + OFF_DUMMY) : (mix + qrow0 * MIXW);
            float sw[4];
#pragma unroll
            for (int cb = 0; cb < 4; ++cb) sw[cb] = p.subln[layer * 128 + 32 * cb + l31] * (1.0f - lam_init);
#pragma unroll
            for (int r = 0; r < 16; ++r) {
                float a[4]; float ss = 0.f;
#pragma unroll
                for (int cb = 0; cb < 4; ++cb) { a[cb] = o[cb][r] - lamv * ex[crow(r, hi) * 128 + 32 * cb + l31]; ss += a[cb] * a[cb]; }
                ss = half_sum32(ss); const float ri = rsqrtf(ss * (1.0f / 128.0f) + EPSN);
                bf16_t* op = obase + (size_t)(32 * qg + crow(r, hi)) * MIXW + h * 128 + l31;
#pragma unroll
                for (int cb = 0; cb < 4; ++cb) op[32 * cb] = f2bf1(a[cb] * ri * sw[cb]);
            }
        }
    }
    __syncthreads();
}

DI int swz16(int row) { return ((row & 3) << 2) | ((row >> 2) & 3); }
constexpr int AT2_TILE = 16384, AT2_BUF = 2 * AT2_TILE, AT2_QS = 2 * AT2_BUF, AT2_LSCR = 131072;
template <bool SHIFT> DI void phase_attn2(const Params& p, const Grp& G, int layer, LAS unsigned char* lds, int tid, int wave, int lane, int vcu, bool dry) {
    bf16_t* mix = (bf16_t*)(p.ws + OFF_BIG + BIG_MIX); const bf16_t* rest = (const bf16_t*)(p.ws + OFF_BIG + BIG_REST);
    const int NQB = G.S / 256, nunits = G.NB * 4 * NQB, NT = G.S / 64;
    const int c = wave >> 2, qg = wave & 3, hi = lane >> 5, l31 = lane & 31, q4 = (lane & 15) >> 2, p4 = lane & 3, blk = (lane >> 4) & 1;
    float bound2 = 0.f;
    if (SHIFT) { const float mq = wave_max(fabsf(p.qn[layer * 64 + lane])), mk = wave_max(fabsf(p.kn[layer * 64 + lane])); bound2 = __uint_as_float(__builtin_amdgcn_readfirstlane(__float_as_uint(8.0f * mq * mk * LOG2E))); }
    LAS float* lscr = (LAS float*)(lds + AT2_LSCR) + wave * 64;
    const int k0 = l31 * 256 + (((8 * c + hi) ^ swz16(l31)) * 16);
    const int v0 = (4 * hi + q4) * 256 + (((2 * blk + (p4 >> 1)) ^ (hi & 3)) * 16) + 8 * (p4 & 1) + (q4 << 6);
    unsigned doff0;
    { const int row = 8 * wave + (lane >> 4); const int ch = (lane & 15) ^ swz16(row); doff0 = (unsigned)(row * RESTW + ch * 8) * 2u; }
    for (int u = vcu; u < nunits; u += gridDim.x) {
        const int qb = u % NQB, bh = u / NQB, h = bh & 3, b = bh >> 2; const size_t seq0 = (size_t)b * G.S; const size_t qrow0 = seq0 + (size_t)qb * 256;
        bf16x8 qf[2][4];
        int lq = (int)__builtin_amdgcn_mbcnt_hi(~0u, __builtin_amdgcn_mbcnt_lo(~0u, 0u)); asm volatile("" : "+v"(lq));
#pragma unroll
        for (int rbq = 0; rbq < 2; ++rbq) { const bf16_t* qp = mix + (qrow0 + 64 * qg + 32 * rbq + (lq & 31)) * MIXW + h * 128 + c * 64 + 8 * (lq >> 5);
#pragma unroll
          for (int d0 = 0; d0 < 4; ++d0) qf[rbq][d0] = *(const bf16x8*)(qp + 16 * d0); }
        LAS unsigned char* Qs = lds + AT2_QS + wave * 8192 + lane * 16;
        const bf16_t* kg = rest + seq0 * RESTW + R_DK + h * 128; const bf16_t* vg = rest + seq0 * RESTW + R_DV + h * 128;
        __syncthreads();
#define AT2_DMA(t_, buf_) do { const char* kb_ = (const char*)(kg + (size_t)(t_) * 64 * RESTW); const char* vb_ = (const char*)(vg + (size_t)(t_) * 64 * RESTW); \
            _Pragma("unroll") for (int i_ = 0; i_ < 2; ++i_) { const unsigned do_ = i_ ? ((dfl ^ 16u) + 4u * RESTW * 2u) : dfl; \
                __builtin_amdgcn_global_load_lds((const unsigned*)(kb_ + do_), (LAS unsigned*)(lds + (buf_) * AT2_BUF + (2 * wave + i_) * 1024), 16, 0, 0); \
                __builtin_amdgcn_global_load_lds((const unsigned*)(vb_ + do_), (LAS unsigned*)(lds + (buf_) * AT2_BUF + AT2_TILE + (2 * wave + i_) * 1024), 16, 0, 0); } } while (0)
        { unsigned dfl = doff0; asm volatile("" : "+v"(dfl)); AT2_DMA(0, 0); }
#pragma unroll
        for (int rbq = 0; rbq < 2; ++rbq)
#pragma unroll
            for (int d0 = 0; d0 < 4; ++d0) *(LAS bf16x8*)(Qs + (rbq * 4 + d0) * 1024) = qf[rbq][d0];
        asm volatile("s_waitcnt vmcnt(0)" ::: "memory");
        __syncthreads();
        f32x16 o[2][4];
#pragma unroll
        for (int a = 0; a < 2; ++a)
#pragma unroll
            for (int cb = 0; cb < 4; ++cb) o[a][cb] = f32x16{};
        float lsum[2] = {0.f, 0.f};
        for (int t = 0; t < NT; ++t) {
            unsigned dfl = doff0; asm volatile("" : "+v"(dfl));
            if (t + 1 < NT) AT2_DMA(t + 1, (t + 1) & 1);
            const LAS unsigned char* Kt = lds + (t & 1) * AT2_BUF; const LAS unsigned char* Vt = Kt + AT2_TILE;
            int k0l = k0, v0l = v0; asm volatile("" : "+v"(k0l), "+v"(v0l));
#define SB() __builtin_amdgcn_sched_barrier(0)
#define KFRAG(rb_, d0_) (*(const LAS bf16x8*)(Kt + (k0l ^ ((d0_) << 5)) + (rb_) * 8192))
#define QFRAG(rbq_, d0_) (*(const LAS bf16x8*)(Qs + ((rbq_) * 4 + (d0_)) * 1024))
#define BFRAG(ks_, cb_) cat8(vtr(Vt + (v0l ^ ((cb_) << 6)) + (ks_) * 4096), vtr(Vt + (v0l ^ (((cb_) << 6) | 32)) + 2048 + (ks_) * 4096))
#define CHAIN(dst_, rb_, rbq_, LDK_, LDQ_) do { asm volatile("" : "+v"(k0l), "+v"(Qs)); \
                if (LDK_) { _Pragma("unroll") for (int d0 = 0; d0 < 4; ++d0) kfs[d0] = KFRAG(rb_, d0); } \
                if (LDQ_) { _Pragma("unroll") for (int d0 = 0; d0 < 4; ++d0) qfs[d0] = QFRAG(rbq_, d0); } \
                SB(); dst_ = f32x16{}; \
                _Pragma("unroll") for (int d0 = 0; d0 < 4; ++d0) dst_ = MFMA32(kfs[d0], qfs[d0], dst_); \
                SB(); } while (0)
#define EXPACK(sc_, rbq_, p0_, p1_) do { float ps_ = 0.f; \
                _Pragma("unroll") for (int r = 0; r < 16; ++r) { sc_[r] = __builtin_amdgcn_exp2f(SHIFT ? sc_[r] - bound2 : sc_[r]); ps_ += sc_[r]; } \
                lsum[rbq_] += ps_; p0_ = pack8(sc_, 0); p1_ = pack8(sc_, 1); } while (0)
#define BLOAD(B_, ks_) do { asm volatile("" : "+v"(v0l)); _Pragma("unroll") for (int cb = 0; cb < 4; ++cb) B_[cb] = BFRAG(ks_, cb); SB(); } while (0)
#define PVMMA(B_, pA_, pB_) do { _Pragma("unroll") for (int cb = 0; cb < 4; ++cb) { o[0][cb] = MFMA32(pA_, B_[cb], o[0][cb]); o[1][cb] = MFMA32(pB_, B_[cb], o[1][cb]); } } while (0)
            {
                f32x16 s0, s1; bf16x8 pa00, pa01, pa10, pa11; bf16x8 kfs[4], qfs[4];
                CHAIN(s0, 0, 0, true, true); CHAIN(s1, 0, 1, false, true);
                EXPACK(s0, 0, pa00, pa01); EXPACK(s1, 1, pa10, pa11);
                SB();
                CHAIN(s1, 1, 1, true, false); CHAIN(s0, 1, 0, false, true);
                bf16x8 pb00, pb01, pb10, pb11; bf16x8 B[4];
                BLOAD(B, 0);
                PVMMA(B, pa00, pa10); EXPACK(s0, 0, pb00, pb01);
                SB();
                BLOAD(B, 1);
                PVMMA(B, pa01, pa11); EXPACK(s1, 1, pb10, pb11);
                SB();
                BLOAD(B, 2);
                PVMMA(B, pb00, pb10);
                SB();
                BLOAD(B, 3);
                PVMMA(B, pb01, pb11);
                SB();
            }
#undef CHAIN
#undef EXPACK
#undef BLOAD
#undef PVMMA
#undef SB
#undef KFRAG
#undef QFRAG
#undef BFRAG
            asm volatile("s_waitcnt vmcnt(0)" ::: "memory");
            __syncthreads();
        }
#undef AT2_DMA
        lsum[0] += __shfl_xor(lsum[0], 32); lsum[1] += __shfl_xor(lsum[1], 32);
        int lanev = (int)__builtin_amdgcn_mbcnt_hi(~0u, __builtin_amdgcn_mbcnt_lo(~0u, 0u)); asm volatile("" : "+v"(lanev));
        const int hiv = lanev >> 5, l31v = lanev & 31;
        if (hiv == 0) { lscr[l31v] = lsum[0]; lscr[32 + l31v] = lsum[1]; }
        __syncthreads();
        bf16_t* obase = dry ? (bf16_t*)(p.ws + OFF_DUMMY) : (mix + qrow0 * MIXW);
        float lamv, lam_init;
        { const float* lp = p.lam + layer * 256; const float s1 = wave_sum(lp[lanev] * lp[64 + lanev]), s2 = wave_sum(lp[128 + lanev] * lp[192 + lanev]);
          lam_init = layer == 0 ? 0.2f : (layer == 1 ? 0.355509068f : (layer == 2 ? 0.470713018f : 0.556058204f));
          lamv = __uint_as_float(__builtin_amdgcn_readfirstlane(__float_as_uint(expf(s1) - expf(s2) + lam_init))); }
        float sw[4];
#pragma unroll
        for (int cb = 0; cb < 4; ++cb) sw[cb] = p.subln[layer * 128 + 32 * cb + l31v] * (1.0f - lam_init);
        LAS float* ex = (LAS float*)lds + qg * 4096;
#pragma unroll
        for (int rbq = 0; rbq < 2; ++rbq) {
#pragma unroll
            for (int r = 0; r < 16; ++r) { const float rl = __builtin_amdgcn_rcpf(lscr[32 * rbq + crow(r, hiv)]);
#pragma unroll
                for (int cb = 0; cb < 4; ++cb) o[rbq][cb][r] *= rl; }
            if (c == 1) {
#pragma unroll
                for (int cb = 0; cb < 4; ++cb)
#pragma unroll
                    for (int r = 0; r < 16; ++r) ex[crow(r, hiv) * 128 + 32 * cb + l31v] = o[rbq][cb][r];
            }
            __syncthreads();
            if (c == 0) {
                LAS unsigned char* stg = lds + AT2_QS + wave * 8192;
#pragma unroll
                for (int r = 0; r < 16; ++r) {
                    float a[4]; float ss = 0.f;
#pragma unroll
                    for (int cb = 0; cb < 4; ++cb) { a[cb] = o[rbq][cb][r] - lamv * ex[crow(r, hiv) * 128 + 32 * cb + l31v]; ss += a[cb] * a[cb]; }
                    ss = half_sum32(ss); const float ri = rsqrtf(ss * (1.0f / 128.0f) + EPSN);
                    LAS bf16_t* sp = (LAS bf16_t*)(stg + crow(r, hiv) * 256) + l31v;
#pragma unroll
                    for (int cb = 0; cb < 4; ++cb) sp[32 * cb] = f2bf1(a[cb] * ri * sw[cb]);
                }
                asm volatile("s_waitcnt lgkmcnt(0)" ::: "memory");
#pragma unroll
                for (int i = 0; i < 8; ++i) { const int q = lanev + 64 * i, row = q >> 4, ch = q & 15;
                    const u32x4 v = *(const LAS u32x4*)(stg + row * 256 + ch * 16);
                    *(u32x4*)(obase + (size_t)(64 * qg + 32 * rbq + row) * MIXW + h * 128 + ch * 8) = v; }
                asm volatile("s_waitcnt lgkmcnt(0)" ::: "memory");
            }
            __syncthreads();
        }
    }
    __syncthreads();
}

#ifndef PROBE_MASK
#define PROBE_MASK 0
#endif
#ifndef PROBE_GEMM
#define PROBE_GEMM 1
#endif
#ifndef PROBE_SYNC
#define PROBE_SYNC 1
#endif
#ifndef PH_MASK
#define PH_MASK 1023
#endif
constexpr int STEPS_PER_LAYER = 8, STEPS_PER_GROUP = 1 + DEPTH * STEPS_PER_LAYER, NSTEPS = 2 * STEPS_PER_GROUP;

__global__ void __launch_bounds__(NTHREADS, 2) mega_fwd(Params p_arg) {
    typedef const __attribute__((address_space(4))) Params* KArgP;
    extern __shared__ __attribute__((aligned(16))) unsigned char lds_raw[];
    LAS unsigned char* lds = (LAS unsigned char*)lds_raw;
    const int GRID = gridDim.x; const int bx = blockIdx.x; const int vcu = (GRID % 8 == 0) ? (bx % 8) * (GRID / 8) + bx / 8 : bx;
    const int NGW = GRID * NWAVES; const int wave0 = __builtin_amdgcn_readfirstlane((int)threadIdx.x >> 6);
    cg::grid_group grid = cg::this_grid();
    volatile LAS unsigned* xst = (volatile LAS unsigned*)(lds + LDS_BYTES - 64);
    if (threadIdx.x == 0) { xst[0] = 0u; xst[1] = 0u; }
    __syncthreads();
    const XcdBarrier xbar = xcd_barrier_post((unsigned*)(p_arg.ws + OFF_CTL), xst);
    const int step_lo = p_arg.step_lo, step_hi = p_arg.step_hi;
    int step_begin = step_lo;
    if (step_begin == 0 && step_hi > 0) {
        const Params p = p_arg;
        const int lane_i = (int)threadIdx.x & 63; const Grp G0 = grp_of(0);
        phase_prep_x(p.x_in[0], (bf16_t*)(p.ws + OFF_XBA), (float*)(p.ws + OFF_RSQ1), G0.M, bx * NWAVES + wave0, NGW, lane_i);
        phase_weights(p, lds, bx * NWAVES + wave0, NGW, wave0, lane_i);
        phase_trig(p, bx * NTHREADS + (int)threadIdx.x, GRID * NTHREADS);
        if (step_hi > 1) grid.sync();
        step_begin = 1;
    }
    for (int step = step_begin; step < step_hi; ++step) {
        KArgP kq = (KArgP)__builtin_amdgcn_kernarg_segment_ptr(); asm volatile("" : "+s"(kq));
        Params p;
        p.x_in[0] = kq->x_in[0]; p.x_in[1] = kq->x_in[1]; p.p_in[0] = kq->p_in[0]; p.p_in[1] = kq->p_in[1];
        p.ln1 = nullptr; p.w_in = nullptr; p.w_out = nullptr; p.ln2 = nullptr; p.w1 = nullptr; p.w2 = nullptr; p.wg = nullptr; p.wp = nullptr;
        p.qn = kq->qn; p.kn = kq->kn; p.lam = kq->lam; p.subln = kq->subln; p.decay = kq->decay; p.gn = kq->gn;
        p.out = kq->out; p.ws = kq->ws; p.step_lo = step_lo; p.step_hi = step_hi;
        int nrep = 1; { const int sg_ = step % STEPS_PER_GROUP; const int ph_ = sg_ > 0 ? (sg_ - 1) % STEPS_PER_LAYER : 8; nrep = ((PROBE_MASK >> ph_) & 1) ? 2 : 1; }
        _Pragma("nounroll") for (int rep = 0; rep < nrep; ++rep) {
        const int wave = wave0; const int gw = bx * NWAVES + wave;
#define FRESH_LANE int lane = (int)__builtin_amdgcn_mbcnt_hi(~0u, __builtin_amdgcn_mbcnt_lo(~0u, 0u)); asm volatile("" : "+v"(lane)); int tid = wave0 * 64 + lane; (void)tid;
        const int g = step / STEPS_PER_GROUP, sg = step % STEPS_PER_GROUP; const Grp G = grp_of(g);
        bf16_t* xbA = (bf16_t*)(p.ws + OFF_XBA); bf16_t* xbB = (bf16_t*)(p.ws + OFF_XBB);
        bf16_t* mix = (bf16_t*)(p.ws + OFF_BIG + BIG_MIX); bf16_t* rest = (bf16_t*)(p.ws + OFF_BIG + BIG_REST); bf16_t* hmid = (bf16_t*)(p.ws + OFF_BIG);
        bf16_t* ptmp = (bf16_t*)(p.ws + OFF_BIG); bf16_t* pb = (bf16_t*)(p.ws + OFF_PB);
        float* rsq1 = (float*)(p.ws + OFF_RSQ1); float* rsq2 = (float*)(p.ws + OFF_RSQ2);
        float* X = p.out + (size_t)G.tok0 * DM;
        if (sg == 0) {
            if (PH_MASK & 512) { FRESH_LANE phase_prep_x(p.x_in[1], xbA, rsq1, G.M, gw, NGW, lane); }
        } else {
            const int layer = (sg - 1) / STEPS_PER_LAYER, ph = (sg - 1) % STEPS_PER_LAYER; const bool dry = rep + 1 < nrep;
            bf16_t* xin_b = (layer & 1) ? xbB : xbA; bf16_t* xoth = (layer & 1) ? xbA : xbB;
            const bf16_t* wt = (const bf16_t*)(p.ws + OFF_WT) + (size_t)layer * WL_SIZE;
            if ((PH_MASK >> ph) & 1) switch (ph) {
            case 0: { FRESH_LANE pg8::Gemm gm{xin_b, wt + WL_IN, G.M, NIN, DM}; pg8::StaticOrder S; S.init(G.M, NIN, GRID, bx); EpiProj E{mix, rest, rsq1, p.qn + layer * 64, p.kn + layer * 64, (const float*)(p.ws + OFF_TRIGD), (const float*)(p.ws + OFF_TRIGR), G.S - 1, (const LAS float*)(lds + RINV_OFF), 0};
                      build_rinv(S, rsq1, (LAS float*)(lds + RINV_OFF), tid);
                      pg8::gemm_phase<EpiProj, pg8::StaticOrder, true, true>(lds, gm, S, E, tid); } break;
            case 1: { FRESH_LANE phase_ret_kv(p, G, layer, lds, tid, wave, lane); } break;
            case 2: { FRESH_LANE phase_ret_scan(p, G, layer, tid, dry); phase_pb(p, G, layer, g, gw, NGW, lane); } break;
            case 3:
#ifndef NO_ATTN
                { int lane1 = (int)__builtin_amdgcn_mbcnt_hi(~0u, __builtin_amdgcn_mbcnt_lo(~0u, 0u)); asm volatile("" : "+v"(lane1));
                  const float mqk = wave_max(fabsf(p.qn[layer * 64 + lane1])) * wave_max(fabsf(p.kn[layer * 64 + lane1]));
                  const bool need_shift = __builtin_amdgcn_readfirstlane((int)(8.0f * mqk * LOG2E > 60.0f)) != 0;
                  if (need_shift) { int la = (int)__builtin_amdgcn_mbcnt_hi(~0u, __builtin_amdgcn_mbcnt_lo(~0u, 0u)); asm volatile("" : "+v"(la)); phase_attn(p, G, layer, lds, wave * 64 + la, wave, la, vcu, dry); }
                  else { int lb = (int)__builtin_amdgcn_mbcnt_hi(~0u, __builtin_amdgcn_mbcnt_lo(~0u, 0u)); asm volatile("" : "+v"(lb)); phase_attn2<false>(p, G, layer, lds, wave * 64 + lb, wave, lb, vcu, dry); } }
#endif
#ifndef NO_RETOUT
                { int lane2 = (int)__builtin_amdgcn_mbcnt_hi(~0u, __builtin_amdgcn_mbcnt_lo(~0u, 0u)); asm volatile("" : "+v"(lane2)); phase_ret_out(p, G, layer, lds, wave * 64 + lane2, wave, lane2, dry); }
#endif
                break;
            case 4: { FRESH_LANE pg8::Gemm gm{mix, wt + WL_OUT, G.M, DM, DM}; pg8::StaticOrder S; S.init(G.M, DM, GRID, bx);
                      EpiResid E{layer == 0 ? (g ? p.x_in[1] : p.x_in[0]) : nullptr, xin_b, xoth, rsq2};
                      pg8::gemm_phase<EpiResid, pg8::StaticOrder, true, true>(lds, gm, S, E, tid); } break;
            case 5: { FRESH_LANE pg8::Gemm gm{xoth, wt + WL_1, G.M, DFF, DM}; pg8::StaticOrder S; S.init(G.M, DFF, GRID, bx); EpiMlp1 E{hmid, rsq2, (const LAS float*)(lds + RINV_OFF), 0};
                      build_rinv(S, rsq2, (LAS float*)(lds + RINV_OFF), tid);
                      pg8::gemm_phase<EpiMlp1, pg8::StaticOrder, true, true>(lds, gm, S, E, tid); } break;
            case 6: { FRESH_LANE pg8::Gemm gm{hmid, wt + WL_2, G.M, DM, DFF}; pg8::StaticOrder S; S.init(G.M, DM, GRID, bx); EpiResid E{nullptr, xoth, xin_b, nullptr};
                      pg8::gemm_phase<EpiResid, pg8::StaticOrder, true, true>(lds, gm, S, E, tid); } break;
            case 7: { FRESH_LANE
#ifndef NO_GP
                      { int kp = PLE; asm volatile("" : "+s"(kp)); pg8::Gemm gm{pb, wt + WL_P, G.M, DM, kp}; pg8::StaticOrder S; S.init(G.M, DM, GRID, bx); EpiP E{ptmp};
                        pg8::gemm_phase<EpiP, pg8::StaticOrder, true, true>(lds, gm, S, E, tid); }
                      __syncthreads(); asm volatile("" : "+v"(tid));
#endif
#ifndef NO_GG
                      { pg8::Gemm gm{xin_b, wt + WL_G, G.M, DM, DM}; pg8::StaticOrder S; S.init(G.M, DM, GRID, bx); EpiGate E{xin_b, ptmp, xoth, rsq1, layer == DEPTH - 1 ? X : nullptr};
                        pg8::gemm_phase<EpiGate, pg8::StaticOrder, true, true>(lds, gm, S, E, tid); }
#endif
                    } break;
            }
        }
        }
        if (step + 1 < step_hi) {
            { for (int rep2 = 0; rep2 < PROBE_SYNC; ++rep2) { int t0 = wave0 * 64 + (int)__builtin_amdgcn_mbcnt_hi(~0u, __builtin_amdgcn_mbcnt_lo(~0u, 0u)); xcd_barrier(xbar, t0); } }
        }
    }
}

#ifndef PH_MASK_UNUSED
#endif
#ifndef MK_MULTI
#define MK_MULTI 0
#endif
extern "C" void kernel_launch(void* const* d_in, const int* in_sizes, int n_in, void* d_out, int out_size, void* d_ws, size_t ws_size, hipStream_t stream) {
    static int grid = 0;
    if (grid == 0) {
        if (n_in != 18 || ws_size < WS_NEED || out_size != 49152 * DM) { fprintf(stderr, "kernel_launch: unexpected sizes (n_in %d, ws %zu need %zu, out %d)\n", n_in, ws_size, (size_t)WS_NEED, out_size); grid = -1; return; }
        int dev = 0, cus = 0, per_cu = 0;
        hipGetDevice(&dev); hipDeviceGetAttribute(&cus, hipDeviceAttributeMultiprocessorCount, dev);
        if (hipFuncSetAttribute((const void*)mega_fwd, hipFuncAttributeMaxDynamicSharedMemorySize, LDS_BYTES) != hipSuccess) { fprintf(stderr, "kernel_launch: hipFuncSetAttribute failed\n"); grid = -1; return; }
        if (hipOccupancyMaxActiveBlocksPerMultiprocessor(&per_cu, (const void*)mega_fwd, NTHREADS, LDS_BYTES) != hipSuccess || per_cu < 1) { fprintf(stderr, "kernel_launch: occupancy query gave %d\n", per_cu); per_cu = 1; }
        (void)hipGetLastError();
        grid = cus * 1;
        fprintf(stderr, "kernel_launch: grid %d (per_cu %d), ws %zu need %zu\n", grid, per_cu, ws_size, (size_t)WS_NEED);
    }
    if (grid < 0) return;
    if (hipMemsetAsync((char*)d_ws + OFF_CTL, 0, CTL_BYTES, stream) != hipSuccess) { fprintf(stderr, "kernel_launch: memset failed\n"); return; }
    Params p{};
    p.x_in[0] = (const float*)d_in[0]; p.x_in[1] = (const float*)d_in[1]; p.p_in[0] = (const float*)d_in[2]; p.p_in[1] = (const float*)d_in[3];
    p.ln1 = (const float*)d_in[4]; p.w_in = (const float*)d_in[5]; p.qn = (const float*)d_in[6]; p.kn = (const float*)d_in[7]; p.lam = (const float*)d_in[8];
    p.subln = (const float*)d_in[9]; p.decay = (const float*)d_in[10]; p.gn = (const float*)d_in[11]; p.w_out = (const float*)d_in[12]; p.ln2 = (const float*)d_in[13];
    p.w1 = (const float*)d_in[14]; p.w2 = (const float*)d_in[15]; p.wg = (const float*)d_in[16]; p.wp = (const float*)d_in[17];
    p.out = (float*)d_out; p.ws = (unsigned char*)d_ws;
#if MK_MULTI
    for (int s = 0; s < NSTEPS; ++s) { p.step_lo = s; p.step_hi = s + 1; hipLaunchKernelGGL(mega_fwd, dim3(grid), dim3(NTHREADS), LDS_BYTES, stream, p); }
#else
    p.step_lo = 0; p.step_hi = NSTEPS;
    void* args[] = {&p};
    hipError_t e = hipLaunchCooperativeKernel((const void*)mega_fwd, dim3(grid), dim3(NTHREADS), args, LDS_BYTES, stream);
    if (e != hipSuccess) fprintf(stderr, "kernel_launch: cooperative launch failed: %s (grid %d)\n", hipGetErrorString(e), grid);
#endif
}
```

```cpp
#include <hip/hip_runtime.h>
#include <hip/hip_cooperative_groups.h>
#include <cstdio>
#include <cstdint>
namespace cg = cooperative_groups;
namespace pg8 {
#define PG8_LAS __attribute__((address_space(3)))
typedef unsigned short bf16_t;
typedef short bf16x8 __attribute__((ext_vector_type(8)));
typedef float f32x4 __attribute__((ext_vector_type(4)));
typedef unsigned u32x4 __attribute__((ext_vector_type(4)));
constexpr int BM = 256, BK = 64, HALF = 128, HTB = HALF * BK * 2  , STAGE_BYTES = 8 * HTB, NXCD = 8, WGM = 8;

__host__ __device__ __forceinline__ int lds_byte(int r, int c) { const int st = (r >> 4) * 2 + (c >> 5), rr = r & 15, cc = c & 31, ob = rr * 64 + cc * 2; return st * 1024 + (ob ^ (((ob >> 9) & 1) << 5)); }
__host__ __device__ __forceinline__ void stage_rc(int b, int& R, int& C) { const int st = b / 1024, sb = b % 1024, swz = sb ^ (((sb >> 9) & 1) << 5); R = (st >> 1) * 16 + swz / 64; C = (st & 1) * 32 + (swz % 64) / 2; }
__host__ __device__ __forceinline__ int perm32(int rho) { const int n = rho >> 4, i = rho & 15; return 8 * (i >> 2) + 4 * n + (i & 3); }

struct Unit { int pm, pn; };
struct Gemm { const bf16_t* A; const bf16_t* Bt; int M, N, K; };

struct StaticOrder {
    int nM, nN, nwg, G, c;
    __host__ __device__ void init(int M, int N, int G_, int c_) { nM = M / BM; nN = N / BM; nwg = nM * nN; G = G_; c = c_; }
    __host__ __device__ bool next(int i, Unit& u) const {
        const long L = (long)i * G + c; if (L >= nwg) return false;
        int wgid = (int)L; { const int q = nwg / NXCD, r = nwg % NXCD, xcd = wgid % NXCD, off = wgid / NXCD; wgid = (xcd < r ? xcd * (q + 1) : r * (q + 1) + (xcd - r) * q) + off; }
        const int nig = WGM * nN, gid = wgid / nig, fm = gid * WGM, gsz = (nM - fm) < WGM ? (nM - fm) : WGM;
        u.pm = fm + ((wgid % nig) % gsz); u.pn = (wgid % nig) / gsz; return true;
    }
    __device__ __forceinline__ void a_ready(const Unit&) const {}
    __device__ __forceinline__ void done(const Unit&) const {}
};

__device__ __forceinline__ unsigned cvt_pk_bf16(float lo, float hi) { unsigned r; asm volatile("v_cvt_pk_bf16_f32 %0, %1, %2" : "=v"(r) : "v"(lo), "v"(hi)); return r; }
template <class Epi, class Sched, bool ALIGN_EPI = false, bool SP2 = false>
__device__ __forceinline__ void gemm_phase(PG8_LAS unsigned char* lds, const Gemm g, const Sched& S, const Epi& E, const int tid) {
    const int wid = __builtin_amdgcn_readfirstlane(tid >> 6), lane = tid & 63, wr = wid >> 2, wc = wid & 3, fr = lane & 15, fq = lane >> 4;
    const int K = g.K, nt = K / BK;
    unsigned voffA[2], voffB[2];
#pragma unroll
    for (int i = 0; i < 2; ++i) { int R, C; stage_rc(tid * 16 + i * 8192, R, C); const int Rb = Epi::PERM ? ((R & ~31) + perm32(R & 31)) : R;
        voffA[i] = (unsigned)(R * K + C) * 2u; voffB[i] = (unsigned)(Rb * K + C) * 2u; }
    const size_t kstep = (size_t)(BK * 2);
    const size_t hstep = (size_t)HALF * K * 2;
    const size_t tstep = 2 * hstep;
    const unsigned ldsw = (unsigned)wid * 1024u;
    const int aoff = lds_byte(wr * 64 + fr, fq * 8), boff = lds_byte(wc * 32 + fr, fq * 8);
#define PG8_SA(b, h) (((b) * 2 + (h)) * HTB)
#define PG8_SB(b, h) ((4 + (b) * 2 + (h)) * HTB)
#define PG8_STAGE(bufoff, gbase, voff) do { _Pragma("unroll") for (int _i = 0; _i < 2; ++_i) \
        __builtin_amdgcn_global_load_lds((const unsigned*)((const char*)(gbase) + (voff)[_i]), (PG8_LAS unsigned*)(lds + (bufoff) + ldsw + _i * 8192), 16, 0, 0); } while (0)
#define PG8_LDA(dst, b, h) do { _Pragma("unroll") for (int m = 0; m < 4; ++m) _Pragma("unroll") for (int k = 0; k < 2; ++k) dst[m][k] = *(const PG8_LAS bf16x8*)(lds + PG8_SA(b, h) + aoff + m * 2048 + k * 1024); } while (0)
#define PG8_LDB(dst, b, h) do { _Pragma("unroll") for (int n = 0; n < 2; ++n) _Pragma("unroll") for (int k = 0; k < 2; ++k) dst[n][k] = *(const PG8_LAS bf16x8*)(lds + PG8_SB(b, h) + boff + n * 2048 + k * 1024); } while (0)
#define PG8_MMA(ai, bj, At, Bt) do { __builtin_amdgcn_s_setprio(1); _Pragma("unroll") for (int m = 0; m < 4; ++m) _Pragma("unroll") for (int n = 0; n < 2; ++n) _Pragma("unroll") for (int k = 0; k < 2; ++k) \
        acc[ai][bj][m][n] = __builtin_amdgcn_mfma_f32_16x16x32_bf16(Bt[n][k], At[m][k], acc[ai][bj][m][n], 0, 0, 0); __builtin_amdgcn_s_setprio(0); } while (0)
#define PG8_WAIT_V(n) asm volatile("s_waitcnt vmcnt(" #n ")" ::: "memory")
#define PG8_WAIT_L(n) asm volatile("s_waitcnt lgkmcnt(" #n ")" ::: "memory")
#define PG8_BAR __builtin_amdgcn_s_barrier()
#define PG8_SCHED __builtin_amdgcn_sched_barrier(0)
    Unit cur, nxt; int ui = 0;
    if (!S.next(0, cur)) return;
    f32x4 acc[2][2][4][2];
#pragma unroll
    for (int a = 0; a < 2; ++a)
#pragma unroll
        for (int b = 0; b < 2; ++b)
#pragma unroll
            for (int m = 0; m < 4; ++m)
#pragma unroll
                for (int n = 0; n < 2; ++n) acc[a][b][m][n] = (f32x4){0.f, 0.f, 0.f, 0.f};
    bf16x8 At[4][2], B0[2][2], B1[2][2];
    const char* cA = (const char*)g.A + (size_t)cur.pm * tstep; const char* cB = (const char*)g.Bt + (size_t)cur.pn * tstep;
    S.a_ready(cur);
    if constexpr (SP2) {
        PG8_STAGE(PG8_SB(0, 0), cB, voffB); PG8_STAGE(PG8_SB(0, 1), cB + hstep, voffB); PG8_STAGE(PG8_SA(0, 0), cA, voffA); PG8_STAGE(PG8_SA(0, 1), cA + hstep, voffA);
        if (wr == 1) PG8_BAR;
        PG8_WAIT_V(2); PG8_BAR;
        PG8_STAGE(PG8_SB(1, 0), cB + kstep, voffB); PG8_STAGE(PG8_SA(1, 0), cA + kstep, voffA); PG8_STAGE(PG8_SB(1, 1), cB + hstep + kstep, voffB);
        PG8_WAIT_V(6); PG8_BAR;
    } else {
        PG8_STAGE(PG8_SB(0, 0), cB, voffB); PG8_STAGE(PG8_SA(0, 0), cA, voffA); PG8_STAGE(PG8_SB(0, 1), cB + hstep, voffB); PG8_STAGE(PG8_SA(0, 1), cA + hstep, voffA);
        if (wr == 1) PG8_BAR;
        PG8_WAIT_V(4); PG8_BAR;
        PG8_STAGE(PG8_SB(1, 0), cB + kstep, voffB); PG8_STAGE(PG8_SA(1, 0), cA + kstep, voffA); PG8_STAGE(PG8_SB(1, 1), cB + hstep + kstep, voffB);
        PG8_WAIT_V(6); PG8_BAR;
    }
    for (;;) {
        const bool has_next = S.next(ui + 1, nxt);
        const char* nA = has_next ? (const char*)g.A + (size_t)nxt.pm * tstep : cA; const char* nB = has_next ? (const char*)g.Bt + (size_t)nxt.pn * tstep : cB;
        for (int t = 0; t < nt; t += 2) {
            const bool last = (t == nt - 2);
            const char* a1 = cA + (size_t)(t + 1) * kstep;
            const char* a2 = last ? nA : cA + (size_t)(t + 2) * kstep; const char* b2 = last ? nB : cB + (size_t)(t + 2) * kstep;
            const char* a3 = a2 + kstep; const char* b3 = b2 + kstep;
            if (last && has_next) S.a_ready(nxt);
            if constexpr (SP2) {
            PG8_LDB(B0, 0, 0); PG8_LDB(B1, 0, 1); PG8_SCHED; PG8_LDA(At, 0, 0); PG8_STAGE(PG8_SA(1, 1), a1 + hstep, voffA);
            PG8_WAIT_V(8); PG8_WAIT_L(0); PG8_BAR; PG8_MMA(0, 0, At, B0); PG8_MMA(0, 1, At, B1); PG8_BAR; PG8_SCHED;
            PG8_LDA(At, 0, 1); PG8_STAGE(PG8_SB(0, 0), b2, voffB); PG8_STAGE(PG8_SB(0, 1), b2 + hstep, voffB); PG8_STAGE(PG8_SA(0, 0), a2, voffA);
            PG8_WAIT_V(8); PG8_WAIT_L(0); PG8_BAR; PG8_MMA(1, 0, At, B0); PG8_MMA(1, 1, At, B1); PG8_BAR; PG8_SCHED;
            PG8_LDB(B0, 1, 0); PG8_LDB(B1, 1, 1); PG8_SCHED; PG8_LDA(At, 1, 0); PG8_STAGE(PG8_SA(0, 1), a2 + hstep, voffA);
            PG8_WAIT_V(8); PG8_WAIT_L(0); PG8_BAR; PG8_MMA(0, 0, At, B0); PG8_MMA(0, 1, At, B1); PG8_BAR; PG8_SCHED;
            PG8_LDA(At, 1, 1); PG8_STAGE(PG8_SB(1, 0), b3, voffB); PG8_STAGE(PG8_SB(1, 1), b3 + hstep, voffB); PG8_STAGE(PG8_SA(1, 0), a3, voffA);
            PG8_WAIT_V(8); PG8_WAIT_L(0); PG8_BAR; PG8_MMA(1, 0, At, B0); PG8_MMA(1, 1, At, B1); PG8_BAR; PG8_SCHED;
            } else {
            PG8_LDB(B0, 0, 0); PG8_SCHED; PG8_LDA(At, 0, 0); PG8_STAGE(PG8_SA(1, 1), a1 + hstep, voffA);
            PG8_WAIT_L(8); PG8_BAR; PG8_WAIT_L(0); PG8_MMA(0, 0, At, B0); PG8_BAR; PG8_SCHED;
            PG8_LDB(B1, 0, 1); PG8_STAGE(PG8_SB(0, 0), b2, voffB);
            PG8_BAR; PG8_WAIT_L(0); PG8_MMA(0, 1, At, B1); PG8_BAR;
            PG8_LDA(At, 0, 1); PG8_STAGE(PG8_SA(0, 0), a2, voffA);
            PG8_BAR; PG8_WAIT_L(0); PG8_MMA(1, 0, At, B0); PG8_BAR; PG8_SCHED;
            PG8_STAGE(PG8_SB(0, 1), b2 + hstep, voffB);
            PG8_WAIT_V(6); PG8_BAR; PG8_MMA(1, 1, At, B1); PG8_BAR;
            PG8_LDB(B0, 1, 0); PG8_SCHED; PG8_LDA(At, 1, 0); PG8_STAGE(PG8_SA(0, 1), a2 + hstep, voffA);
            PG8_WAIT_L(8); PG8_BAR; PG8_WAIT_L(0); PG8_MMA(0, 0, At, B0); PG8_BAR; PG8_SCHED;
            PG8_LDB(B1, 1, 1); PG8_STAGE(PG8_SB(1, 0), b3, voffB);
            PG8_BAR; PG8_WAIT_L(0); PG8_MMA(0, 1, At, B1); PG8_BAR;
            PG8_LDA(At, 1, 1); PG8_STAGE(PG8_SA(1, 0), a3, voffA);
            PG8_BAR; PG8_WAIT_L(0); PG8_MMA(1, 0, At, B0); PG8_BAR; PG8_SCHED;
            PG8_STAGE(PG8_SB(1, 1), b3 + hstep, voffB);
            PG8_WAIT_V(6); PG8_BAR; PG8_MMA(1, 1, At, B1); PG8_BAR;
            }
        }
        if constexpr (ALIGN_EPI) { if (wr == 0) PG8_BAR; }
        if constexpr (!Epi::AFTER_DRAIN) { E(acc, cur, wr, wc, fr, fq); S.done(cur); }
        if (!has_next) break;
#pragma unroll
        for (int a = 0; a < 2; ++a)
#pragma unroll
            for (int b = 0; b < 2; ++b)
#pragma unroll
                for (int m = 0; m < 4; ++m)
#pragma unroll
                    for (int n = 0; n < 2; ++n) acc[a][b][m][n] = (f32x4){0.f, 0.f, 0.f, 0.f};
        cur = nxt; cA = nA; cB = nB; ++ui;
        if constexpr (ALIGN_EPI) { if (wr == 1) PG8_BAR; }
    }
    PG8_WAIT_V(0);
    if constexpr (!ALIGN_EPI) { if (wr == 0) PG8_BAR; }
    PG8_BAR;
    if constexpr (Epi::AFTER_DRAIN) { E.fused(acc, cur, wr, wc, fr, fq, lds, wid, lane); S.done(cur); }
#undef PG8_SA
#undef PG8_SB
#undef PG8_STAGE
#undef PG8_LDA
#undef PG8_LDB
#undef PG8_MMA
#undef PG8_WAIT_V
#undef PG8_WAIT_L
#undef PG8_BAR
#undef PG8_SCHED
}
}
#define DI __device__ __forceinline__
#define LAS __attribute__((address_space(3)))
typedef unsigned short bf16_t;
typedef short bf16x8 __attribute__((ext_vector_type(8)));
typedef short s16x4 __attribute__((ext_vector_type(4)));
typedef float f32x4 __attribute__((ext_vector_type(4)));
typedef float f32x16 __attribute__((ext_vector_type(16)));
typedef unsigned u32x4 __attribute__((ext_vector_type(4)));
typedef unsigned u32x2 __attribute__((ext_vector_type(2)));

constexpr int DM = 1024, NIN = 3584, DFF = 4096, PLE = 256, DEPTH = 4;
constexpr int MIXW = 1024, RESTW = 2560;
constexpr int R_DK = 0, R_DV = 512, R_RK = 1024, R_RV = 1536, R_RG = 2048;
constexpr float EPSN = 1e-6f;
constexpr float LOG2E = 1.4426950408889634f;
constexpr int NTHREADS = 512, NWAVES = 8;
constexpr int LDS_BYTES = 147456;
constexpr int MAXM = 32768;

constexpr size_t WL_IN = 0, WL_OUT = WL_IN + (size_t)NIN * DM, WL_1 = WL_OUT + (size_t)DM * DM, WL_2 = WL_1 + (size_t)DFF * DM,
                 WL_G = WL_2 + (size_t)DM * DFF, WL_P = WL_G + (size_t)DM * DM, WL_SIZE = WL_P + (size_t)DM * PLE;
constexpr size_t OFF_WT = 0;
constexpr size_t OFF_XBA = OFF_WT + WL_SIZE * 2 * DEPTH;
constexpr size_t OFF_XBB = OFF_XBA + (size_t)MAXM * DM * 2;
constexpr size_t OFF_BIG = OFF_XBB + (size_t)MAXM * DM * 2;
constexpr size_t BIG_MIX = 0, BIG_REST = (size_t)MAXM * MIXW * 2, BIG_ST = BIG_REST + (size_t)MAXM * RESTW * 2;
constexpr size_t BIG_SIZE = BIG_ST + (size_t)(MAXM / 128) * 8 * 2 * 4096 * 4;
constexpr size_t OFF_PB = OFF_BIG + BIG_SIZE;
constexpr size_t OFF_RSQ1 = OFF_PB + (size_t)MAXM * PLE * 2;
constexpr size_t OFF_RSQ2 = OFF_RSQ1 + (size_t)MAXM * 16 * 4;
constexpr size_t OFF_ST16 = OFF_RSQ2 + (size_t)MAXM * 16 * 4;
constexpr size_t OFF_CTL = OFF_ST16 + (size_t)(MAXM / 128) * 8 * 2 * 4096 * 2;
constexpr size_t CTL_BYTES = 16384;
constexpr size_t OFF_TRIGR = OFF_CTL + 65536;
constexpr size_t OFF_TRIGD = OFF_TRIGR + (size_t)8192 * 64 * 4;
constexpr size_t OFF_DUMMY = OFF_TRIGD + (size_t)8192 * 16 * 4;
constexpr size_t WS_NEED = OFF_DUMMY + (1u << 20);
static_assert((size_t)MAXM * DFF * 2 <= BIG_SIZE, "hmid overlays proj + states");

__device__ const float ROT_D[8] = {1.f, 0.193922758f, 0.0376060307f, 0.00729266508f, 0.00141421345f, 0.000274248188f, 5.31829646e-05f, 1.03133852e-05f};
__device__ const float ROT_R[32] = {1.f, 0.749894202f, 0.562341332f, 0.421696514f, 0.316227764f, 0.237137392f, 0.177827939f, 0.133352146f, 0.100000001f, 0.0749894157f, 0.0562341288f, 0.0421696492f, 0.0316227786f, 0.0237137359f, 0.0177827943f, 0.0133352149f, 0.00999999978f, 0.00749894232f, 0.00562341325f, 0.00421696482f, 0.00316227786f, 0.00237137382f, 0.00177827943f, 0.00133352145f, 0.00100000005f, 0.000749894185f, 0.000562341302f, 0.000421696546f, 0.000316227786f, 0.000237137385f, 0.00017782794f, 0.00013335215f};

struct Params {
    const float* x_in[2]; const float* p_in[2];
    const float *ln1, *w_in, *qn, *kn, *lam, *subln, *decay, *gn, *w_out, *ln2, *w1, *w2, *wg, *wp;
    float* out; unsigned char* ws;
    int step_lo, step_hi;
};

DI unsigned pk2(float lo, float hi) { typedef float f2 __attribute__((ext_vector_type(2))); typedef __bf16 b2 __attribute__((ext_vector_type(2))); f2 v = {lo, hi}; b2 b = __builtin_convertvector(v, b2); return __builtin_bit_cast(unsigned, b); }
DI float bf_lo(unsigned w) { return __uint_as_float(w << 16); }
DI float bf_hi(unsigned w) { return __uint_as_float(w & 0xffff0000u); }
DI float bf1(bf16_t h) { return __uint_as_float(((unsigned)h) << 16); }
DI bf16_t f2bf1(float f) { return (bf16_t)(pk2(f, 0.f) & 0xffffu); }
DI int crow(int r, int hi) { return (r & 3) + 8 * (r >> 2) + 4 * hi; }
DI float wave_sum(float v) {
#pragma unroll
    for (int o = 1; o < 64; o <<= 1) v += __shfl_xor(v, o);
    return v;
}
DI float wave_max(float v) {
#pragma unroll
    for (int o = 1; o < 64; o <<= 1) v = fmaxf(v, __shfl_xor(v, o));
    return v;
}
DI float half_sum32(float v) {
#pragma unroll
    for (int o = 1; o < 32; o <<= 1) v += __shfl_xor(v, o);
    return v;
}
DI s16x4 vtr(const LAS unsigned char* p) { typedef short v4i16_t __attribute__((ext_vector_type(4))); return __builtin_bit_cast(s16x4, __builtin_amdgcn_ds_read_tr16_b64_v4i16((LAS v4i16_t*)p)); }
DI bf16x8 cat8(s16x4 lo, s16x4 hi) { return (bf16x8){lo[0], lo[1], lo[2], lo[3], hi[0], hi[1], hi[2], hi[3]}; }
#define MFMA32(a, b, c) __builtin_amdgcn_mfma_f32_32x32x16_bf16((a), (b), (c), 0, 0, 0)
DI bf16x8 pack8(const f32x16& x, int s) {
    u32x4 p; p.x = pk2(x[8 * s], x[8 * s + 1]); p.y = pk2(x[8 * s + 2], x[8 * s + 3]); p.z = pk2(x[8 * s + 4], x[8 * s + 5]); p.w = pk2(x[8 * s + 6], x[8 * s + 7]);
    return __builtin_bit_cast(bf16x8, p);
}
DI float rowscale(const float* rsq, int row) {
    const f32x4* p = (const f32x4*)(rsq + (size_t)row * 16);
    f32x4 a = p[0], b = p[1], c = p[2], d = p[3];
    float s = ((a.x + a.y) + (a.z + a.w)) + ((b.x + b.y) + (b.z + b.w)) + ((c.x + c.y) + (c.z + c.w)) + ((d.x + d.y) + (d.z + d.w));
    return rsqrtf(s * (1.0f / DM) + EPSN);
}

constexpr int RINV_OFF = 131072, RINV_SLOTS = 8;
using pg8::Unit; using pg8::BM; using pg8::HALF; using pg8::cvt_pk_bf16;
DI int pi_diff(int s) { return s < 8 ? s : (s < 32 ? s + 8 : (s < 40 ? s - 24 : s)); }
struct EpiProj {
    static constexpr bool PERM = true, AFTER_DRAIN = false;
    bf16_t* mix; bf16_t* rest; const float* rsq; const float* qnw; const float* knw; const float* trigD; const float* trigR; int smask; const LAS float* rtab; mutable int ui;
    DI void operator()(const f32x4 (&acc)[2][2][4][2], const Unit& u, int wr, int wc, int fr, int fq) const {
        const int row0 = u.pm * BM + wr * 64 + fr; const int type = u.pn >> 1; const int slot = ui++; const LAS float* rt = rtab + slot * 256 + wr * 64 + fr;
        bf16_t* base; int ld, colt;
        if (u.pn < 4) { base = mix; ld = MIXW; colt = u.pn * BM; } else { base = rest; ld = RESTW; colt = (u.pn - 4) * BM; }
        const int col0 = colt + 64 * wc + 8 * fq;
        const bool isnorm = (type == 0) || (type == 2), isrot = (type == 1) || (type == 4);
        const float osc = type == 0 ? (0.125f * LOG2E) : (type == 4 ? 0.125f : 1.0f);
        f32x4 w[2][2];
        if (isnorm) { const float* wp = type == 0 ? qnw : knw;
#pragma unroll
            for (int bj = 0; bj < 2; ++bj)
#pragma unroll
                for (int n = 0; n < 2; ++n)
#pragma unroll
                    for (int j = 0; j < 4; ++j) w[bj][n][j] = wp[pi_diff(32 * bj + 8 * fq + 4 * n + j)]; }
#pragma unroll
        for (int ai = 0; ai < 2; ++ai)
#pragma unroll
            for (int m = 0; m < 4; ++m) {
                const int row = row0 + ai * HALF + m * 16; const float ri = slot < RINV_SLOTS ? rt[ai * HALF + m * 16] : rowscale(rsq, row); const int pos = row & smask;
                f32x4 v[2][2];
#pragma unroll
                for (int bj = 0; bj < 2; ++bj)
#pragma unroll
                    for (int n = 0; n < 2; ++n) v[bj][n] = acc[ai][bj][m][n] * ri;
                if (isnorm) {
                    float ss = 0.f;
#pragma unroll
                    for (int bj = 0; bj < 2; ++bj)
#pragma unroll
                        for (int n = 0; n < 2; ++n) ss += (v[bj][n][0] * v[bj][n][0] + v[bj][n][1] * v[bj][n][1]) + (v[bj][n][2] * v[bj][n][2] + v[bj][n][3] * v[bj][n][3]);
                    ss += __shfl_xor(ss, 16); ss += __shfl_xor(ss, 32);
                    const float rn = rsqrtf(ss * (1.0f / 64.0f) + EPSN);
#pragma unroll
                    for (int bj = 0; bj < 2; ++bj)
#pragma unroll
                        for (int n = 0; n < 2; ++n) v[bj][n] = v[bj][n] * rn * w[bj][n];
                    if (fq == 0) { const float* t = trigD + (size_t)pos * 16;
#pragma unroll
                        for (int n = 0; n < 2; ++n) { const f32x4 c4 = *(const f32x4*)(t + 4 * n), s4 = *(const f32x4*)(t + 8 + 4 * n); const f32x4 x1 = v[0][n], x2 = v[1][n];
                            v[0][n] = x1 * c4 - x2 * s4; v[1][n] = x1 * s4 + x2 * c4; } }
                } else if (isrot) { const float* t = trigR + (size_t)pos * 64 + 8 * fq;
#pragma unroll
                    for (int n = 0; n < 2; ++n) { const f32x4 c4 = *(const f32x4*)(t + 4 * n), s4 = *(const f32x4*)(t + 32 + 4 * n); const f32x4 x1 = v[0][n], x2 = v[1][n];
                        v[0][n] = x1 * c4 - x2 * s4; v[1][n] = x1 * s4 + x2 * c4; }
                }
                bf16_t* rowp = base + (size_t)row * ld + col0;
#pragma unroll
                for (int bj = 0; bj < 2; ++bj) { const f32x4 v0 = v[bj][0] * osc, v1 = v[bj][1] * osc;
                    u32x4 o; o.x = pk2(v0[0], v0[1]); o.y = pk2(v0[2], v0[3]); o.z = pk2(v1[0], v1[1]); o.w = pk2(v1[2], v1[3]);
                    *(u32x4*)(rowp + 32 * bj) = o; }
            }
    }
};
struct EpiMlp1 {
    static constexpr bool PERM = true, AFTER_DRAIN = false;
    bf16_t* O; const float* rsq; const LAS float* rtab; mutable int ui;
    DI void operator()(const f32x4 (&acc)[2][2][4][2], const Unit& u, int wr, int wc, int fr, int fq) const {
        const int row0 = u.pm * BM + wr * 64 + fr; const int col0 = u.pn * BM + wc * 32 + 8 * fq; const int slot = ui++; const LAS float* rt = rtab + slot * 256 + wr * 64 + fr;
#pragma unroll
        for (int ai = 0; ai < 2; ++ai)
#pragma unroll
            for (int m = 0; m < 4; ++m) {
                const int row = row0 + ai * HALF + m * 16; const float ri = slot < RINV_SLOTS ? rt[ai * HALF + m * 16] : rowscale(rsq, row);
                bf16_t* rowp = O + (size_t)row * DFF + col0;
#pragma unroll
                for (int bj = 0; bj < 2; ++bj) { f32x4 v0 = acc[ai][bj][m][0] * ri, v1 = acc[ai][bj][m][1] * ri;
#pragma unroll
                    for (int j = 0; j < 4; ++j) { float a = fmaxf(v0[j], 0.f), b = fmaxf(v1[j], 0.f); v0[j] = a * a; v1[j] = b * b; }
                    u32x4 w; w.x = pk2(v0[0], v0[1]); w.y = pk2(v0[2], v0[3]); w.z = pk2(v1[0], v1[1]); w.w = pk2(v1[2], v1[3]);
                    *(u32x4*)(rowp + bj * HALF) = w; }
            }
    }
};
struct EpiP {
    static constexpr bool PERM = true, AFTER_DRAIN = false;
    bf16_t* O;
    DI void operator()(const f32x4 (&acc)[2][2][4][2], const Unit& u, int wr, int wc, int fr, int fq) const {
        const int row0 = u.pm * BM + wr * 64 + fr; const int col0 = u.pn * BM + wc * 32 + 8 * fq;
#pragma unroll
        for (int ai = 0; ai < 2; ++ai)
#pragma unroll
            for (int m = 0; m < 4; ++m) { bf16_t* rowp = O + (size_t)(row0 + ai * HALF + m * 16) * DM + col0;
#pragma unroll
                for (int bj = 0; bj < 2; ++bj) { const f32x4 v0 = acc[ai][bj][m][0], v1 = acc[ai][bj][m][1];
                    u32x4 w; w.x = pk2(v0[0], v0[1]); w.y = pk2(v0[2], v0[3]); w.z = pk2(v1[0], v1[1]); w.w = pk2(v1[2], v1[3]); *(u32x4*)(rowp + bj * HALF) = w; } }
    }
};
struct EpiResid {
    static constexpr bool PERM = true, AFTER_DRAIN = false;
    const float* xf; const bf16_t* xh; bf16_t* xb; float* rsq;
    DI void operator()(const f32x4 (&acc)[2][2][4][2], const Unit& u, int wr, int wc, int fr, int fq) const {
        const int row0 = u.pm * BM + wr * 64 + fr; const int col0 = u.pn * BM + wc * 32 + 8 * fq;
        if (xf) {
#pragma unroll
            for (int ai = 0; ai < 2; ++ai) { f32x4 xv[4][2][2];
#pragma unroll
                for (int m = 0; m < 4; ++m)
#pragma unroll
                    for (int bj = 0; bj < 2; ++bj) { const size_t o = (size_t)(row0 + ai * HALF + m * 16) * DM + col0 + bj * HALF; xv[m][bj][0] = *(const f32x4*)(xf + o); xv[m][bj][1] = *(const f32x4*)(xf + o + 4); }
                asm volatile("" ::: "memory");
#pragma unroll
                for (int m = 0; m < 4; ++m) { const int row = row0 + ai * HALF + m * 16; const size_t off = (size_t)row * DM + col0; float ss = 0.f;
#pragma unroll
                    for (int bj = 0; bj < 2; ++bj) { const size_t o = off + bj * HALF; const f32x4 v0 = xv[m][bj][0] + acc[ai][bj][m][0], v1 = xv[m][bj][1] + acc[ai][bj][m][1];
                        u32x4 w; w.x = pk2(v0[0], v0[1]); w.y = pk2(v0[2], v0[3]); w.z = pk2(v1[0], v1[1]); w.w = pk2(v1[2], v1[3]); *(u32x4*)(xb + o) = w;
                        ss += ((v0[0] * v0[0] + v0[1] * v0[1]) + (v0[2] * v0[2] + v0[3] * v0[3])) + ((v1[0] * v1[0] + v1[1] * v1[1]) + (v1[2] * v1[2] + v1[3] * v1[3])); }
                    if (rsq) { ss += __shfl_xor(ss, 16); ss += __shfl_xor(ss, 32); if (fq == 0) rsq[(size_t)row * 16 + u.pn * 4 + wc] = ss; } }
                asm volatile("" ::: "memory"); }
        } else {
            u32x4 hv[2][4][2];
#pragma unroll
            for (int ai = 0; ai < 2; ++ai)
#pragma unroll
                for (int m = 0; m < 4; ++m)
#pragma unroll
                    for (int bj = 0; bj < 2; ++bj) hv[ai][m][bj] = *(const u32x4*)(xh + (size_t)(row0 + ai * HALF + m * 16) * DM + col0 + bj * HALF);
            asm volatile("" ::: "memory");
#pragma unroll
            for (int ai = 0; ai < 2; ++ai)
#pragma unroll
                for (int m = 0; m < 4; ++m) { const int row = row0 + ai * HALF + m * 16; const size_t off = (size_t)row * DM + col0; float ss = 0.f;
#pragma unroll
                    for (int bj = 0; bj < 2; ++bj) { const size_t o = off + bj * HALF; const u32x4 h = hv[ai][m][bj];
                        const f32x4 v0 = (f32x4){bf_lo(h.x), bf_hi(h.x), bf_lo(h.y), bf_hi(h.y)} + acc[ai][bj][m][0], v1 = (f32x4){bf_lo(h.z), bf_hi(h.z), bf_lo(h.w), bf_hi(h.w)} + acc[ai][bj][m][1];
                        u32x4 w; w.x = pk2(v0[0], v0[1]); w.y = pk2(v0[2], v0[3]); w.z = pk2(v1[0], v1[1]); w.w = pk2(v1[2], v1[3]); *(u32x4*)(xb + o) = w;
                        ss += ((v0[0] * v0[0] + v0[1] * v0[1]) + (v0[2] * v0[2] + v0[3] * v0[3])) + ((v1[0] * v1[0] + v1[1] * v1[1]) + (v1[2] * v1[2] + v1[3] * v1[3])); }
                    if (rsq) { ss += __shfl_xor(ss, 16); ss += __shfl_xor(ss, 32); if (fq == 0) rsq[(size_t)row * 16 + u.pn * 4 + wc] = ss; } }
        }
    }
};
struct EpiGate {
    static constexpr bool PERM = true, AFTER_DRAIN = false;
    const bf16_t* xh; const bf16_t* P; bf16_t* xb; float* rsq; float* yout;
    DI void operator()(const f32x4 (&acc)[2][2][4][2], const Unit& u, int wr, int wc, int fr, int fq) const {
        const int row0 = u.pm * BM + wr * 64 + fr; const int col0 = u.pn * BM + wc * 32 + 8 * fq;
#pragma unroll
        for (int ai = 0; ai < 2; ++ai) {
            u32x4 pv[4][2], hv[4][2];
#pragma unroll
            for (int m = 0; m < 4; ++m)
#pragma unroll
                for (int bj = 0; bj < 2; ++bj) { const size_t o = (size_t)(row0 + ai * HALF + m * 16) * DM + col0 + bj * HALF; pv[m][bj] = *(const u32x4*)(P + o); hv[m][bj] = *(const u32x4*)(xh + o); }
            asm volatile("" ::: "memory");
#pragma unroll
            for (int m = 0; m < 4; ++m) { const int row = row0 + ai * HALF + m * 16; const size_t off = (size_t)row * DM + col0; float ss = 0.f;
#pragma unroll
                for (int bj = 0; bj < 2; ++bj) { const size_t o = off + bj * HALF; const f32x4 g0 = acc[ai][bj][m][0], g1 = acc[ai][bj][m][1]; const u32x4 pw = pv[m][bj]; const u32x4 h = hv[m][bj];
                    f32x4 v0 = (f32x4){bf_lo(h.x), bf_hi(h.x), bf_lo(h.y), bf_hi(h.y)}, v1 = (f32x4){bf_lo(h.z), bf_hi(h.z), bf_lo(h.w), bf_hi(h.w)};
                    v0[0] += bf_lo(pw.x) * __builtin_amdgcn_rcpf(1.f + __expf(-g0[0])); v0[1] += bf_hi(pw.x) * __builtin_amdgcn_rcpf(1.f + __expf(-g0[1]));
                    v0[2] += bf_lo(pw.y) * __builtin_amdgcn_rcpf(1.f + __expf(-g0[2])); v0[3] += bf_hi(pw.y) * __builtin_amdgcn_rcpf(1.f + __expf(-g0[3]));
                    v1[0] += bf_lo(pw.z) * __builtin_amdgcn_rcpf(1.f + __expf(-g1[0])); v1[1] += bf_hi(pw.z) * __builtin_amdgcn_rcpf(1.f + __expf(-g1[1]));
                    v1[2] += bf_lo(pw.w) * __builtin_amdgcn_rcpf(1.f + __expf(-g1[2])); v1[3] += bf_hi(pw.w) * __builtin_amdgcn_rcpf(1.f + __expf(-g1[3]));
                    if (yout) { *(f32x4*)(yout + o) = v0; *(f32x4*)(yout + o + 4) = v1; }
                    u32x4 w; w.x = pk2(v0[0], v0[1]); w.y = pk2(v0[2], v0[3]); w.z = pk2(v1[0], v1[1]); w.w = pk2(v1[2], v1[3]); *(u32x4*)(xb + o) = w;
                    ss += ((v0[0] * v0[0] + v0[1] * v0[1]) + (v0[2] * v0[2] + v0[3] * v0[3])) + ((v1[0] * v1[0] + v1[1] * v1[1]) + (v1[2] * v1[2] + v1[3] * v1[3])); }
                ss += __shfl_xor(ss, 16); ss += __shfl_xor(ss, 32); if (fq == 0) rsq[(size_t)row * 16 + u.pn * 4 + wc] = ss; }
            asm volatile("" ::: "memory");
        }
    }
};

DI void build_rinv(const pg8::StaticOrder& S, const float* rsq, LAS float* tab, int tid) {
    const int r = tid & 255;
#pragma unroll 1
    for (int i = tid >> 8; i < RINV_SLOTS; i += 2) { Unit u; if (!S.next(i, u)) break; tab[i * 256 + r] = rowscale(rsq, u.pm * BM + r); }
    __syncthreads();
}
#define XB_TMO      128
#define XB_XCNT(j)  (256  + 64 * (j))
#define XB_XSUB(j)  (1280 + 64 * (j))
#define XB_XGEN(j)  (2304 + 64 * (j))
#define XB_TOP      3328
#define XB_TOPGEN   3392
#define XCD_BAR_WORDS 3456
#define XB_SPIN_CAP (1u << 18)

__device__ __forceinline__ unsigned xb_ld(unsigned* p)              { return __hip_atomic_load(p, __ATOMIC_RELAXED, __HIP_MEMORY_SCOPE_AGENT); }
__device__ __forceinline__ unsigned xb_add(unsigned* p, unsigned v) { return __hip_atomic_fetch_add(p, v, __ATOMIC_RELAXED, __HIP_MEMORY_SCOPE_AGENT); }
__device__ __forceinline__ unsigned xb_xcc_id() { return (unsigned)__builtin_amdgcn_s_getreg((3 << 11) | 20) & 0xFu; }
#define XB_SPIN(cond, bar) do { unsigned _sp = 0; while (cond) { __builtin_amdgcn_s_sleep(1); \
    if ((++_sp & 255u) == 0u) { if (xb_ld(&(bar)[XB_TMO])) break; if (_sp > XB_SPIN_CAP) { atomicAdd(&(bar)[XB_TMO], 1u); break; } } } } while (0)

struct XcdBarrier {
    unsigned* bar; unsigned x;
    volatile LAS unsigned* st;
};

__device__ __forceinline__ XcdBarrier xcd_barrier_post(unsigned* bar, volatile LAS unsigned* st) {
    XcdBarrier b; b.bar = bar; b.x = xb_xcc_id(); b.st = st;
    if (threadIdx.x == 0) (void)xb_add(&bar[XB_XCNT(b.x)], 1u);
    return b;
}
__device__ __forceinline__ void xcd_barrier_complete(unsigned* bar, unsigned x, unsigned& nloc, unsigned& nx) {
    const unsigned G = gridDim.x * gridDim.y * gridDim.z;
    unsigned sum, cnt, mine, sp = 0u;
    for (;;) {
        sum = 0u; cnt = 0u; mine = 0u;
#pragma unroll
        for (unsigned j = 0; j < 16; ++j) { const unsigned c = xb_ld(&bar[XB_XCNT(j)]); sum += c; cnt += (c > 0u) ? 1u : 0u; mine = (j == x) ? c : mine; }
        if (sum == G) break;
        __builtin_amdgcn_s_sleep(1);
        if ((++sp & 255u) == 0u) { if (xb_ld(&bar[XB_TMO])) break; if (sp > XB_SPIN_CAP) { atomicAdd(&bar[XB_TMO], 1u); break; } }
    }
    nloc = mine > 0u ? mine : 1u; nx = cnt > 0u ? cnt : 1u;
}

__device__ __forceinline__ void xcd_barrier(const XcdBarrier& b, const int tid) {
    asm volatile("s_waitcnt vmcnt(0)" ::: "memory");
    __syncthreads();
    if (tid == 0) {
        unsigned* bar = b.bar;
        __builtin_amdgcn_s_waitcnt(0);
        unsigned nloc = b.st[0], nx = b.st[1];
        if (nloc == 0u) { xcd_barrier_complete(bar, b.x, nloc, nx); b.st[0] = nloc; b.st[1] = nx; }
        const unsigned old = xb_add(&bar[XB_XSUB(b.x)], 1u);
        const unsigned gen = old / nloc;
        if (old + 1u == (gen + 1u) * nloc) {
            __builtin_amdgcn_fence(__ATOMIC_RELEASE, "agent");
            asm volatile("s_waitcnt vmcnt(0)" ::: "memory");
            const unsigned og = xb_add(&bar[XB_TOP], 1u);
            const unsigned tg = og / nx;
            if (og + 1u == (tg + 1u) * nx) xb_add(&bar[XB_TOPGEN], 1u);
            else XB_SPIN(xb_ld(&bar[XB_TOPGEN]) == tg, bar);
            __builtin_amdgcn_fence(__ATOMIC_ACQUIRE, "agent");
            xb_add(&bar[XB_XGEN(b.x)], 1u);
            asm volatile("s_waitcnt vmcnt(0)" ::: "memory");
        } else {
            XB_SPIN(xb_ld(&bar[XB_XGEN(b.x)]) == gen, bar);
            __builtin_amdgcn_fence(__ATOMIC_ACQUIRE, "agent");
            asm volatile("s_waitcnt vmcnt(0)" ::: "memory");
        }
    }
    __syncthreads();
}

struct Grp { int NB, S, M, tok0; };
DI Grp grp_of(int g) { Grp G; if (g == 0) { G.NB = 2; G.S = 8192; G.M = 16384; G.tok0 = 0; } else { G.NB = 8; G.S = 4096; G.M = 32768; G.tok0 = 16384; } return G; }

DI int remap_in(int n) {
    const int blk = n >> 9, r = n & 511; const int ob = (blk == 0) ? 0 : (blk == 1) ? 3 : (blk == 2) ? 1 : (blk == 3) ? 2 : blk; return ob * 512 + r;
}
DI int win_src_col(int n) {
    const int pn = n >> 8, r = n & 255, bj = r >> 7, wc = (r >> 5) & 3, off = r & 31; int s = 32 * bj + off;
    if (pn == 0 || pn == 1 || pn == 4 || pn == 5) s = pi_diff(s);
    return remap_in(256 * pn + 64 * wc + s);
}
DI void transpose_item(const float* W, int K, int N, bf16_t* WT, const float* kscale, bool remap, LAS float* scr, int item, int lane) {
    const int nblk = N / 64, kb = item / nblk, nb = item % nblk, k0 = 64 * kb, n0 = 64 * nb; const int cg = lane & 15;
    const int scol = remap ? win_src_col(n0 + 4 * cg) : n0 + 4 * cg;
#pragma unroll 8
    for (int i = 0; i < 16; ++i) { const int kk = 4 * i + (lane >> 4); f32x4 v = *(const f32x4*)(W + (size_t)(k0 + kk) * N + scol); if (kscale) v = v * kscale[k0 + kk];
        LAS float* d = scr + kk * 65 + 4 * cg; d[0] = v[0]; d[1] = v[1]; d[2] = v[2]; d[3] = v[3]; }
    asm volatile("s_waitcnt lgkmcnt(0)" ::: "memory");
    const int c = lane & 7;
#pragma unroll
    for (int j = 0; j < 8; ++j) { const int n = (lane >> 3) + 8 * j; const LAS float* s = scr + (8 * c) * 65 + n;
        u32x4 o; o.x = pk2(s[0 * 65], s[1 * 65]); o.y = pk2(s[2 * 65], s[3 * 65]); o.z = pk2(s[4 * 65], s[5 * 65]); o.w = pk2(s[6 * 65], s[7 * 65]);
        *(u32x4*)(WT + (size_t)(n0 + n) * K + k0 + 8 * c) = o; }
    asm volatile("s_waitcnt lgkmcnt(0)" ::: "memory");
}
DI void phase_weights(const Params& p, LAS unsigned char* lds, int gw, int NGW, int wave, int lane) {
    LAS float* scr = (LAS float*)(lds + wave * 16896);
    constexpr int I_IN = (DM / 64) * (NIN / 64), I_OUT = (DM / 64) * (DM / 64), I_1 = (DM / 64) * (DFF / 64), I_2 = (DFF / 64) * (DM / 64), I_G = I_OUT, I_P = (PLE / 64) * (DM / 64);
    constexpr int PER_L = I_IN + I_OUT + I_1 + I_2 + I_G + I_P;
    for (int it = gw; it < PER_L * DEPTH; it += NGW) {
        const int L = it / PER_L; int r = it % PER_L;
        bf16_t* wt = (bf16_t*)(p.ws + OFF_WT) + (size_t)L * WL_SIZE;
        if (r < I_IN) { transpose_item(p.w_in + (size_t)L * DM * NIN, DM, NIN, wt + WL_IN, p.ln1 + L * DM, true, scr, r, lane); continue; } r -= I_IN;
        if (r < I_OUT) { transpose_item(p.w_out + (size_t)L * DM * DM, DM, DM, wt + WL_OUT, nullptr, false, scr, r, lane); continue; } r -= I_OUT;
        if (r < I_1) { transpose_item(p.w1 + (size_t)L * DM * DFF, DM, DFF, wt + WL_1, p.ln2 + L * DM, false, scr, r, lane); continue; } r -= I_1;
        if (r < I_2) { transpose_item(p.w2 + (size_t)L * DFF * DM, DFF, DM, wt + WL_2, nullptr, false, scr, r, lane); continue; } r -= I_2;
        if (r < I_G) { transpose_item(p.wg + (size_t)L * DM * DM, DM, DM, wt + WL_G, nullptr, false, scr, r, lane); continue; } r -= I_G;
        transpose_item(p.wp + (size_t)L * PLE * DM, PLE, DM, wt + WL_P, nullptr, false, scr, r, lane);
    }
}
DI void phase_prep_x(const float* x, bf16_t* xb, float* rsq, int M, int gw, int NGW, int lane) {
    for (int m = gw; m < M; m += NGW) {
        const f32x4* xr = (const f32x4*)(x + (size_t)m * DM) + lane; u32x2* o = (u32x2*)(xb + (size_t)m * DM) + lane; float s = 0.f;
#pragma unroll
        for (int j = 0; j < 4; ++j) { const f32x4 v = xr[64 * j]; s += (v.x * v.x + v.y * v.y) + (v.z * v.z + v.w * v.w); u32x2 w; w.x = pk2(v.x, v.y); w.y = pk2(v.z, v.w); o[64 * j] = w; }
        s = wave_sum(s);
        if (lane < 16) rsq[(size_t)m * 16 + lane] = (lane == 0) ? s : 0.f;
    }
}
DI void sincos_rev(float ang, float& s, float& c) {
    double rev = (double)ang * 0.15915494309189535; rev -= __builtin_rint(rev); const float fr = (float)rev;
    s = __builtin_amdgcn_sinf(fr); c = __builtin_amdgcn_cosf(fr);
}
DI void phase_trig(const Params& p, int gthread, int nthreads) {
    float* tr = (float*)(p.ws + OFF_TRIGR); float* td = (float*)(p.ws + OFF_TRIGD);
    for (int i = gthread; i < 8192 * 40; i += nthreads) { const int pos = i / 40, f = i % 40; float sn, cs;
        if (f < 32) { sincos_rev((float)pos * ROT_R[f], sn, cs); tr[(size_t)pos * 64 + f] = cs; tr[(size_t)pos * 64 + 32 + f] = sn; }
        else { sincos_rev((float)pos * ROT_D[f - 32], sn, cs); td[(size_t)pos * 16 + (f - 32)] = cs; td[(size_t)pos * 16 + 8 + (f - 32)] = sn; } }
}
DI void phase_pb(const Params& p, const Grp& G, int layer, int g, int gw, int NGW, int lane) {
    bf16_t* pb = (bf16_t*)(p.ws + OFF_PB); const float* pin = (g ? p.p_in[1] : p.p_in[0]) + (size_t)layer * G.M * PLE;
    for (int m = gw; m < G.M; m += NGW) { const f32x4 v = *((const f32x4*)(pin + (size_t)m * PLE) + lane); u32x2 w; w.x = pk2(v.x, v.y); w.y = pk2(v.z, v.w); *((u32x2*)(pb + (size_t)m * PLE) + lane) = w; }
}
DI void rot_token(const Params& p, int layer, float pos, int l8, const float (&qw)[8], const float (&kw)[8], const u32x4 (&win)[4], u32x4 (&wout)[4]) {
    float cd[8], sd[8];
    if (l8 < 2) {
#pragma unroll
        for (int e = 0; e < 8; ++e) sincos_rev(pos * ROT_D[e], sd[e], cd[e]);
    } else {
#pragma unroll
        for (int e = 0; e < 8; ++e) { sd[e] = 0.f; cd[e] = 1.f; }
    }
#pragma unroll
    for (int which = 0; which < 2; ++which) {
        const u32x4 w = win[which]; float v[8] = {bf_lo(w.x), bf_hi(w.x), bf_lo(w.y), bf_hi(w.y), bf_lo(w.z), bf_hi(w.z), bf_lo(w.w), bf_hi(w.w)};
        float ss = 0.f;
#pragma unroll
        for (int e = 0; e < 8; ++e) ss += v[e] * v[e];
        ss += __shfl_xor(ss, 1); ss += __shfl_xor(ss, 2); ss += __shfl_xor(ss, 4);
        const float ri = rsqrtf(ss * (1.0f / 64.0f) + EPSN);
#pragma unroll
        for (int e = 0; e < 8; ++e) v[e] = v[e] * ri * (which == 0 ? qw[e] : kw[e]);
        float o[8];
#pragma unroll
        for (int e = 0; e < 8; ++e) { const float pr = __shfl_xor(v[e], 1);
            o[e] = (l8 == 0) ? (v[e] * cd[e] - pr * sd[e]) : (l8 == 1) ? (pr * sd[e] + v[e] * cd[e]) : v[e]; }
        const float sc = which == 0 ? (0.125f * LOG2E) : 1.0f;
        u32x4 r; r.x = pk2(o[0] * sc, o[1] * sc); r.y = pk2(o[2] * sc, o[3] * sc); r.z = pk2(o[4] * sc, o[5] * sc); r.w = pk2(o[6] * sc, o[7] * sc);
        wout[which] = r;
    }
    float cr[8], sr[8];
#pragma unroll
    for (int e = 0; e < 8; ++e) sincos_rev(pos * ROT_R[(l8 & 3) * 8 + e], sr[e], cr[e]);
#pragma unroll
    for (int which = 0; which < 2; ++which) {
        const u32x4 w = win[2 + which]; float v[8] = {bf_lo(w.x), bf_hi(w.x), bf_lo(w.y), bf_hi(w.y), bf_lo(w.z), bf_hi(w.z), bf_lo(w.w), bf_hi(w.w)};
        float o[8];
#pragma unroll
        for (int e = 0; e < 8; ++e) { const float pr = __shfl_xor(v[e], 4);
            o[e] = (l8 < 4) ? (v[e] * cr[e] - pr * sr[e]) : (pr * sr[e] + v[e] * cr[e]); }
        const float sc = which == 0 ? 1.0f : 0.125f;
        u32x4 r; r.x = pk2(o[0] * sc, o[1] * sc); r.y = pk2(o[2] * sc, o[3] * sc); r.z = pk2(o[4] * sc, o[5] * sc); r.w = pk2(o[6] * sc, o[7] * sc);
        wout[2 + which] = r;
    }
}
DI void phase_rot(const Params& p, const Grp& G, int layer, int g, int gw, int NGW, int lane, bool dry) {
    bf16_t* mix = (bf16_t*)(p.ws + OFF_BIG + BIG_MIX); bf16_t* rest = (bf16_t*)(p.ws + OFF_BIG + BIG_REST); bf16_t* pb = (bf16_t*)(p.ws + OFF_PB);
    bf16_t* omix = dry ? (bf16_t*)(p.ws + OFF_DUMMY) : mix; bf16_t* orest = dry ? (bf16_t*)(p.ws + OFF_DUMMY) : rest; const size_t omask = dry ? 63 : ~(size_t)0;
    const float* pin = (g ? p.p_in[1] : p.p_in[0]) + (size_t)layer * G.M * PLE;
    const int l8 = lane & 7, d0 = l8 * 8;
    float qw[8], kw[8];
#pragma unroll
    for (int e = 0; e < 8; ++e) { qw[e] = p.qn[layer * 64 + d0 + e]; kw[e] = p.kn[layer * 64 + d0 + e]; }
    for (int m0 = gw; m0 < G.M; m0 += 2 * NGW) {
        u32x4 win[2][4], wout[2][4]; f32x4 pv[2];
#pragma unroll
        for (int t = 0; t < 2; ++t) { const size_t m = (size_t)m0 + (size_t)t * NGW;
            win[t][0] = *(const u32x4*)(mix + m * MIXW + lane * 8); win[t][1] = *(const u32x4*)(rest + m * RESTW + R_DK + lane * 8);
            win[t][2] = *(const u32x4*)(mix + m * MIXW + 512 + lane * 8); win[t][3] = *(const u32x4*)(rest + m * RESTW + R_RK + lane * 8);
            pv[t] = *((const f32x4*)(pin + m * PLE) + lane); }
#pragma unroll
        for (int t = 0; t < 2; ++t) { const size_t m = (size_t)m0 + (size_t)t * NGW;
            rot_token(p, layer, (float)((int)m % G.S), l8, qw, kw, win[t], wout[t]);
            const size_t mo = m & omask;
            *(u32x4*)(omix + mo * MIXW + lane * 8) = wout[t][0]; *(u32x4*)(orest + mo * RESTW + R_DK + lane * 8) = wout[t][1];
            *(u32x4*)(omix + mo * MIXW + 512 + lane * 8) = wout[t][2]; *(u32x4*)(orest + mo * RESTW + R_RK + lane * 8) = wout[t][3];
            u32x2 w; w.x = pk2(pv[t].x, pv[t].y); w.y = pk2(pv[t].z, pv[t].w); *((u32x2*)(pb + m * PLE) + lane) = w; }
    }
}
DI float log2_gamma(const float* decay, int layer, int dir, int head) {
    const float xl = decay[layer * 16 + dir * 8 + head]; return -log1pf(expf(-xl)) * LOG2E;
}
constexpr int RP = 272;
DI void phase_ret_kv(const Params& p, const Grp& G, int layer, LAS unsigned char* lds, int tid, int wave, int lane) {
    const bf16_t* rest = (const bf16_t*)(p.ws + OFF_BIG + BIG_REST); bf16_t* ST = (bf16_t*)(p.ws + OFF_ST16);
    const int NC = G.S / 128, nunits = G.NB * NC * 4;
    LAS unsigned char* Kt = lds; LAS unsigned char* Vf = lds + 128 * RP; LAS unsigned char* Vb = lds + 2 * 128 * RP;
    const int hh = wave >> 2, ti = (wave >> 1) & 1, tj = wave & 1, hi = lane >> 5, q4 = (lane & 15) >> 2, p4 = lane & 3, blk = (lane >> 4) & 1;
    u32x4 pk[4], pv[4];
#define R1_ISSUE(u_) do { const int hp_ = (u_) & 3, c_ = ((u_) >> 2) % NC, b_ = ((u_) >> 2) / NC; const size_t r0_ = (size_t)b_ * G.S + (size_t)c_ * 128; \
        int tv_ = tid; asm volatile("" : "+v"(tv_)); \
        _Pragma("unroll") for (int i = 0; i < 4; ++i) { const int q = tv_ + 512 * i, row = q >> 4, ch = q & 15; const bf16_t* src = rest + (r0_ + row) * RESTW + hp_ * 128 + ch * 8; \
            pk[i] = *(const u32x4*)(src + R_RK); pv[i] = *(const u32x4*)(src + R_RV); } } while (0)
    if ((int)blockIdx.x < nunits) R1_ISSUE((int)blockIdx.x);
    for (int u = blockIdx.x; u < nunits; u += gridDim.x) {
        const int hp = u & 3, c = (u >> 2) % NC, b = (u >> 2) / NC;
        const float lgf_s = log2_gamma(p.decay, layer, 0, 2 * hp + ((tid & 15) >> 3)), lgb_s = log2_gamma(p.decay, layer, 1, 2 * hp + ((tid & 15) >> 3));
        __syncthreads();
#pragma unroll
        for (int i = 0; i < 4; ++i) { const int q = tid + 512 * i, row = q >> 4, ch = q & 15;
            const u32x4 kv = pk[i]; const u32x4 vv = pv[i];
            *(LAS u32x4*)(Kt + row * RP + ch * 16) = kv;
            const float df = __builtin_amdgcn_exp2f(lgf_s * (float)(127 - row)), db = __builtin_amdgcn_exp2f(lgb_s * (float)row);
            u32x4 a, bb;
            a.x = pk2(bf_lo(vv.x) * df, bf_hi(vv.x) * df); a.y = pk2(bf_lo(vv.y) * df, bf_hi(vv.y) * df); a.z = pk2(bf_lo(vv.z) * df, bf_hi(vv.z) * df); a.w = pk2(bf_lo(vv.w) * df, bf_hi(vv.w) * df);
            bb.x = pk2(bf_lo(vv.x) * db, bf_hi(vv.x) * db); bb.y = pk2(bf_lo(vv.y) * db, bf_hi(vv.y) * db); bb.z = pk2(bf_lo(vv.z) * db, bf_hi(vv.z) * db); bb.w = pk2(bf_lo(vv.w) * db, bf_hi(vv.w) * db);
            *(LAS u32x4*)(Vf + row * RP + ch * 16) = a; *(LAS u32x4*)(Vb + row * RP + ch * 16) = bb; }
        if (u + (int)gridDim.x < nunits) R1_ISSUE(u + (int)gridDim.x);
        __syncthreads();
        f32x16 af = {}, ab = {};
#pragma unroll
        for (int s = 0; s < 8; ++s) {
            const int rowa = (16 * s + 8 * hi + q4) * RP;
            const int cola = (hh * 64 + 32 * ti + 16 * blk + 4 * p4) * 2, colb = (hh * 64 + 32 * tj + 16 * blk + 4 * p4) * 2;
            const bf16x8 A = cat8(vtr(Kt + rowa + cola), vtr(Kt + rowa + 4 * RP + cola));
            const bf16x8 Bf = cat8(vtr(Vf + rowa + colb), vtr(Vf + rowa + 4 * RP + colb));
            const bf16x8 Bb = cat8(vtr(Vb + rowa + colb), vtr(Vb + rowa + 4 * RP + colb));
            af = MFMA32(A, Bf, af); ab = MFMA32(A, Bb, ab);
        }
        __syncthreads();
        { LAS bf16_t* img = (LAS bf16_t*)lds + hh * 8192;
#pragma unroll
          for (int r = 0; r < 16; ++r) { const int i = 32 * ti + crow(r, hi), j = 32 * tj + (lane & 31); img[i * 64 + j] = f2bf1(af[r]); img[4096 + i * 64 + j] = f2bf1(ab[r]); } }
        __syncthreads();
#pragma unroll
        for (int i = 0; i < 4; ++i) { const int q = tid + 512 * i, h2 = q >> 10, w = q & 1023;
            *(u32x4*)(ST + ((size_t)((b * 8 + 2 * hp + h2) * NC + c) * 2) * 4096 + w * 8) = *(const LAS u32x4*)((LAS bf16_t*)lds + h2 * 8192 + w * 8); }
    }
#undef R1_ISSUE
}
DI void phase_ret_scan(const Params& p, const Grp& G, int layer, int tid, bool dry) {
    bf16_t* S16 = (bf16_t*)(p.ws + OFF_ST16); const int NC = G.S / 128; const int total = G.NB * 8 * 2 * 512;
    for (int t = blockIdx.x * NTHREADS + tid; t < total; t += gridDim.x * NTHREADS) {
        const int e = (t & 511) * 8, dir = (t >> 9) & 1, bh = t >> 10, head = bh & 7;
        const float cd = __builtin_amdgcn_exp2f(log2_gamma(p.decay, layer, dir, head) * 128.0f);
        bf16_t* base = S16 + ((size_t)bh * NC * 2 + dir) * 4096 + e; float run[8];
#pragma unroll
        for (int k = 0; k < 8; ++k) run[k] = 0.f;
#define SCAN_STEP(idx_) do { const u32x4 kv_ = kvv[idx_]; u32x4 w_; w_.x = pk2(run[0], run[1]); w_.y = pk2(run[2], run[3]); w_.z = pk2(run[4], run[5]); w_.w = pk2(run[6], run[7]); \
            *(u32x4*)(base + (size_t)(c0 + (idx_)) * 8192) = w_; \
            run[0] = run[0] * cd + bf_lo(kv_.x); run[1] = run[1] * cd + bf_hi(kv_.x); run[2] = run[2] * cd + bf_lo(kv_.y); run[3] = run[3] * cd + bf_hi(kv_.y); \
            run[4] = run[4] * cd + bf_lo(kv_.z); run[5] = run[5] * cd + bf_hi(kv_.z); run[6] = run[6] * cd + bf_lo(kv_.w); run[7] = run[7] * cd + bf_hi(kv_.w); } while (0)
        if (dir == 0) {
            for (int c0 = 0; c0 < NC; c0 += 8) { u32x4 kvv[8];
#pragma unroll
                for (int i = 0; i < 8; ++i) kvv[i] = *(const u32x4*)(base + (size_t)(c0 + i) * 8192);
#pragma unroll
                for (int i = 0; i < 8; ++i) SCAN_STEP(i); }
        } else {
            for (int c0 = NC - 8; c0 >= 0; c0 -= 8) { u32x4 kvv[8];
#pragma unroll
                for (int i = 0; i < 8; ++i) kvv[i] = *(const u32x4*)(base + (size_t)(c0 + i) * 8192);
#pragma unroll
                for (int i = 7; i >= 0; --i) SCAN_STEP(i); }
        }
#undef SCAN_STEP
    }
}
constexpr int R3_S = 2 * 128 * RP;
DI void phase_ret_out(const Params& p, const Grp& G, int layer, LAS unsigned char* lds, int tid, int wave, int lane, bool dry) {
    bf16_t* mix = (bf16_t*)(p.ws + OFF_BIG + BIG_MIX); const bf16_t* rest = (const bf16_t*)(p.ws + OFF_BIG + BIG_REST); const bf16_t* ST = (const bf16_t*)(p.ws + OFF_ST16);
    const int NC = G.S / 128, nunits = G.NB * NC * 4;
    LAS unsigned char* Kt = lds; LAS unsigned char* Vt = lds + 128 * RP; LAS bf16_t* Sl = (LAS bf16_t*)(lds + R3_S);
    const int hh = wave >> 2, qg = wave & 3, hi = lane >> 5, l31 = lane & 31, q4 = (lane & 15) >> 2, p4 = lane & 3, blk = (lane >> 4) & 1;
    u32x4 pk[4], pv[4], ps[4];
#define R3_ISSUE(u_) do { const int hp_ = (u_) & 3, c_ = ((u_) >> 2) % NC, b_ = ((u_) >> 2) / NC; const size_t r0_ = (size_t)b_ * G.S + (size_t)c_ * 128; \
        int tv_ = tid; asm volatile("" : "+v"(tv_)); \
        _Pragma("unroll") for (int i = 0; i < 4; ++i) { const int q = tv_ + 512 * i, row = q >> 4, ch = q & 15; const bf16_t* src = rest + (r0_ + row) * RESTW + hp_ * 128 + ch * 8; \
            pk[i] = *(const u32x4*)(src + R_RK); pv[i] = *(const u32x4*)(src + R_RV); } \
        _Pragma("unroll") for (int i = 0; i < 4; ++i) { const int q = tv_ + 512 * i, h2 = q >> 10, w = q & 1023; \
            ps[i] = *(const u32x4*)(ST + ((size_t)((b_ * 8 + 2 * hp_ + h2) * NC + c_) * 2) * 4096 + w * 8); } } while (0)
    if ((int)blockIdx.x < nunits) R3_ISSUE((int)blockIdx.x);
    for (int u = blockIdx.x; u < nunits; u += gridDim.x) {
        const int hp = u & 3, c = (u >> 2) % NC, b = (u >> 2) / NC; const size_t row0 = (size_t)b * G.S + (size_t)c * 128; const int head = 2 * hp + hh;
        __syncthreads();
        int tidv = tid; asm volatile("" : "+v"(tidv));
#pragma unroll
        for (int i = 0; i < 4; ++i) { const int q = tidv + 512 * i, row = q >> 4, ch = q & 15;
            *(LAS u32x4*)(Kt + row * RP + ch * 16) = pk[i]; *(LAS u32x4*)(Vt + row * RP + ch * 16) = pv[i]; }
#pragma unroll
        for (int i = 0; i < 4; ++i) { const int q = tidv + 512 * i, h2 = q >> 10, w = q & 1023; *(LAS u32x4*)(Sl + h2 * 8192 + w * 8) = ps[i]; }
        bf16x8 qf[4];
        { const bf16_t* qp = mix + (row0 + 32 * qg + l31) * MIXW + 512 + head * 64 + 8 * hi;
#pragma unroll
          for (int d0 = 0; d0 < 4; ++d0) qf[d0] = *(const bf16x8*)(qp + 16 * d0); }
        u32x4 gwv[4];
        { int lv0 = lane; asm volatile("" : "+v"(lv0)); const bf16_t* gb0 = rest + (row0 + 32 * qg) * RESTW + R_RG + head * 64;
#pragma unroll
          for (int i = 0; i < 4; ++i) { const int q = lv0 + 64 * i; gwv[i] = *(const u32x4*)(gb0 + (size_t)(q >> 3) * RESTW + (q & 7) * 8); } }
        if (u + (int)gridDim.x < nunits) R3_ISSUE(u + (int)gridDim.x);
        const float lgf = log2_gamma(p.decay, layer, 0, head), lgb = log2_gamma(p.decay, layer, 1, head);
        __syncthreads();
        f32x16 o[2]; o[0] = f32x16{}; o[1] = f32x16{};
        const int nl = 32 * qg + l31;
#pragma unroll 1
        for (int rb = 0; rb < 4; ++rb) {
            f32x16 sacc = {};
#pragma unroll
            for (int d0 = 0; d0 < 4; ++d0) { const bf16x8 A = *(const LAS bf16x8*)(Kt + (32 * rb + l31) * RP + (hh * 64 + 16 * d0 + 8 * hi) * 2); sacc = MFMA32(A, qf[d0], sacc); }
#pragma unroll
            for (int r = 0; r < 16; ++r) { const int mloc = 32 * rb + crow(r, hi); const int df = nl - mloc; const float D = df >= 0 ? __builtin_amdgcn_exp2f(lgf * (float)df) : __builtin_amdgcn_exp2f(lgb * (float)(-df)); sacc[r] *= D; }
#pragma unroll
            for (int s2 = 0; s2 < 2; ++s2) { const bf16x8 A = pack8(sacc, s2); const int rowa = (32 * rb + 16 * s2 + 4 * hi + q4) * RP;
#pragma unroll
                for (int cb = 0; cb < 2; ++cb) { const int colb = (hh * 64 + 32 * cb + 16 * blk + 4 * p4) * 2;
                    const bf16x8 B = cat8(vtr(Vt + rowa + colb), vtr(Vt + rowa + 8 * RP + colb)); o[cb] = MFMA32(A, B, o[cb]); } }
        }
#pragma unroll 1
        for (int dir = 0; dir < 2; ++dir) {
            const LAS bf16_t* S = Sl + (hh * 2 + dir) * 4096; f32x16 t[2]; t[0] = f32x16{}; t[1] = f32x16{};
#pragma unroll
            for (int ks = 0; ks < 4; ++ks) {
#pragma unroll
                for (int cb = 0; cb < 2; ++cb) { const LAS bf16_t* sp = S + (16 * ks + 8 * hi) * 64 + 32 * cb + l31;
                    u32x4 w; w.x = (unsigned)sp[0] | ((unsigned)sp[64] << 16); w.y = (unsigned)sp[128] | ((unsigned)sp[192] << 16); w.z = (unsigned)sp[256] | ((unsigned)sp[320] << 16); w.w = (unsigned)sp[384] | ((unsigned)sp[448] << 16);
                    t[cb] = MFMA32(qf[ks], __builtin_bit_cast(bf16x8, w), t[cb]); }
                asm volatile("" ::: "memory"); }
#pragma unroll
            for (int r = 0; r < 16; ++r) { const int nrow = 32 * qg + crow(r, hi); const float sc = dir == 0 ? __builtin_amdgcn_exp2f(lgf * (float)(nrow + 1)) : __builtin_amdgcn_exp2f(lgb * (float)(128 - nrow));
                o[0][r] += t[0][r] * sc; o[1][r] += t[1][r] * sc; }
        }
        const float g0 = p.gn[layer * 64 + l31], g1 = p.gn[layer * 64 + 32 + l31];
        __syncthreads();
        LAS float* stg = (LAS float*)(lds + wave * 8192);
#pragma unroll
        for (int r = 0; r < 16; ++r) {
            float ss = o[0][r] * o[0][r] + o[1][r] * o[1][r]; ss = half_sum32(ss); const float ri = rsqrtf(ss * (1.0f / 64.0f) + EPSN);
            LAS float* sp = stg + crow(r, hi) * 64 + l31; sp[0] = o[0][r] * ri * g0; sp[32] = o[1][r] * ri * g1;
        }
        asm volatile("s_waitcnt lgkmcnt(0)" ::: "memory");
        { int lv = lane; asm volatile("" : "+v"(lv));
          bf16_t* ob = (dry ? (bf16_t*)(p.ws + OFF_DUMMY) : mix + row0 * MIXW) + (size_t)(32 * qg) * MIXW + 512 + head * 64; const bf16_t* gb = rest + (row0 + 32 * qg) * RESTW + R_RG + head * 64;
#pragma unroll
          for (int i = 0; i < 4; ++i) { const int q = lv + 64 * i, row = q >> 3, ch = q & 7;
            const f32x4 a0 = *(const LAS f32x4*)(stg + row * 64 + ch * 8), a1 = *(const LAS f32x4*)(stg + row * 64 + ch * 8 + 4);
            const u32x4 gw = gwv[i];
            float gv[8] = {bf_lo(gw.x), bf_hi(gw.x), bf_lo(gw.y), bf_hi(gw.y), bf_lo(gw.z), bf_hi(gw.z), bf_lo(gw.w), bf_hi(gw.w)}; float ov[8];
#pragma unroll
            for (int e = 0; e < 8; ++e) ov[e] = (e < 4 ? a0[e & 3] : a1[e & 3]) * (gv[e] * __builtin_amdgcn_rcpf(1.f + __expf(-gv[e])));
            u32x4 w; w.x = pk2(ov[0], ov[1]); w.y = pk2(ov[2], ov[3]); w.z = pk2(ov[4], ov[5]); w.w = pk2(ov[6], ov[7]);
            *(u32x4*)(ob + (size_t)row * MIXW + ch * 8) = w; } }
    }
#undef R3_ISSUE
}
constexpr int VP = 320;
constexpr int ATT_BUF = 64 * RP + 64 * VP;
constexpr int ATT_LSCR = 2 * ATT_BUF;
DI void phase_attn(const Params& p, const Grp& G, int layer, LAS unsigned char* lds, int tid, int wave, int lane, int vcu, bool dry) {
    bf16_t* mix = (bf16_t*)(p.ws + OFF_BIG + BIG_MIX); const bf16_t* rest = (const bf16_t*)(p.ws + OFF_BIG + BIG_REST);
    const int NQB = G.S / 128, nunits = G.NB * 4 * NQB, NT = G.S / 64;
    const int c = wave >> 2, qg = wave & 3, hi = lane >> 5, l31 = lane & 31, q4 = (lane & 15) >> 2, p4 = lane & 3, blk = (lane >> 4) & 1;
    float lamv, bound2;
    { const float* lp = p.lam + layer * 256; const float s1 = wave_sum(lp[lane] * lp[64 + lane]), s2 = wave_sum(lp[128 + lane] * lp[192 + lane]);
      const float lam_init = 0.8f - 0.6f * expf(-0.3f * (float)layer); lamv = expf(s1) - expf(s2) + lam_init;
      const float mq = wave_max(fabsf(p.qn[layer * 64 + lane])), mk = wave_max(fabsf(p.kn[layer * 64 + lane])); bound2 = 8.0f * mq * mk * LOG2E; }
    const float lam_init = 0.8f - 0.6f * expf(-0.3f * (float)layer);
    LAS float* lscr = (LAS float*)(lds + ATT_LSCR) + wave * 32;
    const int lrow = tid >> 4, lch = tid & 15;
    for (int u = vcu; u < nunits; u += gridDim.x) {
        const int qb = u % NQB, bh = u / NQB, h = bh & 3, b = bh >> 2; const size_t seq0 = (size_t)b * G.S; const size_t qrow0 = seq0 + (size_t)qb * 128;
        bf16x8 qf[4];
        { const bf16_t* qp = mix + (qrow0 + 32 * qg + l31) * MIXW + h * 128 + c * 64 + 8 * hi;
#pragma unroll
          for (int d0 = 0; d0 < 4; ++d0) qf[d0] = *(const bf16x8*)(qp + 16 * d0); }
        const bf16_t* kbase = rest + (seq0 + lrow) * RESTW + R_DK + h * 128 + lch * 8; const bf16_t* vbase = rest + (seq0 + lrow) * RESTW + R_DV + h * 128 + lch * 8;
        u32x4 gk0, gk1, gv0, gv1;
        gk0 = *(const u32x4*)kbase; gk1 = *(const u32x4*)(kbase + (size_t)32 * RESTW); gv0 = *(const u32x4*)vbase; gv1 = *(const u32x4*)(vbase + (size_t)32 * RESTW);
        __syncthreads();
        { LAS unsigned char* Kt = lds; LAS unsigned char* Vt = lds + 64 * RP;
          *(LAS u32x4*)(Kt + lrow * RP + lch * 16) = gk0; *(LAS u32x4*)(Kt + (lrow + 32) * RP + lch * 16) = gk1;
          *(LAS u32x4*)(Vt + lrow * VP + lch * 16) = gv0; *(LAS u32x4*)(Vt + (lrow + 32) * VP + lch * 16) = gv1; }
        __syncthreads();
        f32x16 o[4]; o[0] = f32x16{}; o[1] = f32x16{}; o[2] = f32x16{}; o[3] = f32x16{};
        float lsum = 0.f;
        for (int t = 0; t < NT; ++t) {
            if (t + 1 < NT) { const size_t adv = (size_t)(t + 1) * 64 * RESTW;
                gk0 = *(const u32x4*)(kbase + adv); gk1 = *(const u32x4*)(kbase + adv + (size_t)32 * RESTW); gv0 = *(const u32x4*)(vbase + adv); gv1 = *(const u32x4*)(vbase + adv + (size_t)32 * RESTW); }
            LAS unsigned char* Kt = lds + (t & 1) * ATT_BUF; LAS unsigned char* Vt = Kt + 64 * RP;
            bf16x8 pa[4];
#pragma unroll
            for (int rb = 0; rb < 2; ++rb) {
                f32x16 s = {};
#pragma unroll
                for (int d0 = 0; d0 < 4; ++d0) { const bf16x8 A = *(const LAS bf16x8*)(Kt + (32 * rb + l31) * RP + (c * 64 + 16 * d0 + 8 * hi) * 2); s = MFMA32(A, qf[d0], s); }
                float ps = 0.f;
#pragma unroll
                for (int r = 0; r < 16; ++r) { s[r] = __builtin_amdgcn_exp2f(s[r] - bound2); ps += s[r]; }
                lsum += ps;
                pa[2 * rb] = pack8(s, 0); pa[2 * rb + 1] = pack8(s, 1);
            }
#pragma unroll
            for (int ks = 0; ks < 4; ++ks) { const int rowa = (16 * ks + 4 * hi + q4) * VP;
#pragma unroll
                for (int cb = 0; cb < 4; ++cb) { const int colb = (32 * cb + 16 * blk + 4 * p4) * 2;
                    const bf16x8 B = cat8(vtr(Vt + rowa + colb), vtr(Vt + rowa + 8 * VP + colb)); o[cb] = MFMA32(pa[ks], B, o[cb]); } }
            if (t + 1 < NT) { LAS unsigned char* Kn = lds + ((t + 1) & 1) * ATT_BUF; LAS unsigned char* Vn = Kn + 64 * RP;
                *(LAS u32x4*)(Kn + lrow * RP + lch * 16) = gk0; *(LAS u32x4*)(Kn + (lrow + 32) * RP + lch * 16) = gk1;
                *(LAS u32x4*)(Vn + lrow * VP + lch * 16) = gv0; *(LAS u32x4*)(Vn + (lrow + 32) * VP + lch * 16) = gv1; }
            __syncthreads();
        }
        lsum += __shfl_xor(lsum, 32);
        if (hi == 0) lscr[l31] = lsum;
        __syncthreads();
        float rl[16];
#pragma unroll
        for (int r = 0; r < 16; ++r) rl[r] = __builtin_amdgcn_rcpf(lscr[crow(r, hi)]);
#pragma unroll
        for (int cb = 0; cb < 4; ++cb)
#pragma unroll
            for (int r = 0; r < 16; ++r) o[cb][r] *= rl[r];
        LAS float* ex = (LAS float*)lds + qg * 4096;
        if (c == 1) {
#pragma unroll
            for (int cb = 0; cb < 4; ++cb)
#pragma unroll
                for (int r = 0; r < 16; ++r) ex[crow(r, hi) * 128 + 32 * cb + l31] = o[cb][r];
        }
        __syncthreads();
        if (c == 0) {
            bf16_t* obase = dry ? (bf16_t*)(p.ws + OFF_DUMMY) : (mix + qrow0 * MIXW);
            float sw[4];
#pragma unroll
            for (int cb = 0; cb < 4; ++cb) sw[cb] = p.subln[layer * 128 + 32 * cb + l31] * (1.0f - lam_init);
#pragma unroll
            for (int r = 0; r < 16; ++r) {
                float a[4]; float ss = 0.f;
#pragma unroll
                for (int cb = 0; cb < 4; ++cb) { a[cb] = o[cb][r] - lamv * ex[crow(r, hi) * 128 + 32 * cb + l31]; ss += a[cb] * a[cb]; }
                ss = half_sum32(ss); const float ri = rsqrtf(ss * (1.0f / 128.0f) + EPSN);
                bf16_t* op = obase + (size_t)(32 * qg + crow(r, hi)) * MIXW + h * 128 + l31;
#pragma unroll
                for (int cb = 0; cb < 4; ++cb) op[32 * cb] = f2bf1(a[cb] * ri * sw[cb]);
            }
        }
    }
    __syncthreads();
}

DI int swz16(int row) { return ((row & 3) << 2) | ((row >> 2) & 3); }
constexpr int AT2_TILE = 16384, AT2_BUF = 2 * AT2_TILE, AT2_QS = 2 * AT2_BUF, AT2_LSCR = 131072;
template <bool SHIFT> DI void phase_attn2(const Params& p, const Grp& G, int layer, LAS unsigned char* lds, int tid, int wave, int lane, int vcu, bool dry) {
    bf16_t* mix = (bf16_t*)(p.ws + OFF_BIG + BIG_MIX); const bf16_t* rest = (const bf16_t*)(p.ws + OFF_BIG + BIG_REST);
    const int NQB = G.S / 256, nunits = G.NB * 4 * NQB, NT = G.S / 64;
    const int c = wave >> 2, qg = wave & 3, hi = lane >> 5, l31 = lane & 31, q4 = (lane & 15) >> 2, p4 = lane & 3, blk = (lane >> 4) & 1;
    float bound2 = 0.f;
    if (SHIFT) { const float mq = wave_max(fabsf(p.qn[layer * 64 + lane])), mk = wave_max(fabsf(p.kn[layer * 64 + lane])); bound2 = __uint_as_float(__builtin_amdgcn_readfirstlane(__float_as_uint(8.0f * mq * mk * LOG2E))); }
    LAS float* lscr = (LAS float*)(lds + AT2_LSCR) + wave * 64;
    const int k0 = l31 * 256 + (((8 * c + hi) ^ swz16(l31)) * 16);
    const int v0 = (4 * hi + q4) * 256 + (((2 * blk + (p4 >> 1)) ^ (hi & 3)) * 16) + 8 * (p4 & 1) + (q4 << 6);
    unsigned doff0;
    { const int row = 8 * wave + (lane >> 4); const int ch = (lane & 15) ^ swz16(row); doff0 = (unsigned)(row * RESTW + ch * 8) * 2u; }
    for (int u = vcu; u < nunits; u += gridDim.x) {
        const int qb = u % NQB, bh = u / NQB, h = bh & 3, b = bh >> 2; const size_t seq0 = (size_t)b * G.S; const size_t qrow0 = seq0 + (size_t)qb * 256;
        bf16x8 qf[2][4];
        int lq = (int)__builtin_amdgcn_mbcnt_hi(~0u, __builtin_amdgcn_mbcnt_lo(~0u, 0u)); asm volatile("" : "+v"(lq));
#pragma unroll
        for (int rbq = 0; rbq < 2; ++rbq) { const bf16_t* qp = mix + (qrow0 + 64 * qg + 32 * rbq + (lq & 31)) * MIXW + h * 128 + c * 64 + 8 * (lq >> 5);
#pragma unroll
          for (int d0 = 0; d0 < 4; ++d0) qf[rbq][d0] = *(const bf16x8*)(qp + 16 * d0); }
        LAS unsigned char* Qs = lds + AT2_QS + wave * 8192 + lane * 16;
        const bf16_t* kg = rest + seq0 * RESTW + R_DK + h * 128; const bf16_t* vg = rest + seq0 * RESTW + R_DV + h * 128;
        __syncthreads();
#define AT2_DMA(t_, buf_) do { const char* kb_ = (const char*)(kg + (size_t)(t_) * 64 * RESTW); const char* vb_ = (const char*)(vg + (size_t)(t_) * 64 * RESTW); \
            _Pragma("unroll") for (int i_ = 0; i_ < 2; ++i_) { const unsigned do_ = i_ ? ((dfl ^ 16u) + 4u * RESTW * 2u) : dfl; \
                __builtin_amdgcn_global_load_lds((const unsigned*)(kb_ + do_), (LAS unsigned*)(lds + (buf_) * AT2_BUF + (2 * wave + i_) * 1024), 16, 0, 0); \
                __builtin_amdgcn_global_load_lds((const unsigned*)(vb_ + do_), (LAS unsigned*)(lds + (buf_) * AT2_BUF + AT2_TILE + (2 * wave + i_) * 1024), 16, 0, 0); } } while (0)
        { unsigned dfl = doff0; asm volatile("" : "+v"(dfl)); AT2_DMA(0, 0); }
#pragma unroll
        for (int rbq = 0; rbq < 2; ++rbq)
#pragma unroll
            for (int d0 = 0; d0 < 4; ++d0) *(LAS bf16x8*)(Qs + (rbq * 4 + d0) * 1024) = qf[rbq][d0];
        asm volatile("s_waitcnt vmcnt(0)" ::: "memory");
        __syncthreads();
        f32x16 o[2][4];
#pragma unroll
        for (int a = 0; a < 2; ++a)
#pragma unroll
            for (int cb = 0; cb < 4; ++cb) o[a][cb] = f32x16{};
        float lsum[2] = {0.f, 0.f};
        for (int t = 0; t < NT; ++t) {
            unsigned dfl = doff0; asm volatile("" : "+v"(dfl));
            if (t + 1 < NT) AT2_DMA(t + 1, (t + 1) & 1);
            const LAS unsigned char* Kt = lds + (t & 1) * AT2_BUF; const LAS unsigned char* Vt = Kt + AT2_TILE;
            int k0l = k0, v0l = v0; asm volatile("" : "+v"(k0l), "+v"(v0l));
#define SB() __builtin_amdgcn_sched_barrier(0)
#define KFRAG(rb_, d0_) (*(const LAS bf16x8*)(Kt + (k0l ^ ((d0_) << 5)) + (rb_) * 8192))
#define QFRAG(rbq_, d0_) (*(const LAS bf16x8*)(Qs + ((rbq_) * 4 + (d0_)) * 1024))
#define BFRAG(ks_, cb_) cat8(vtr(Vt + (v0l ^ ((cb_) << 6)) + (ks_) * 4096), vtr(Vt + (v0l ^ (((cb_) << 6) | 32)) + 2048 + (ks_) * 4096))
#define CHAIN(dst_, rb_, rbq_, LDK_, LDQ_) do { asm volatile("" : "+v"(k0l), "+v"(Qs)); \
                if (LDK_) { _Pragma("unroll") for (int d0 = 0; d0 < 4; ++d0) kfs[d0] = KFRAG(rb_, d0); } \
                if (LDQ_) { _Pragma("unroll") for (int d0 = 0; d0 < 4; ++d0) qfs[d0] = QFRAG(rbq_, d0); } \
                SB(); dst_ = f32x16{}; \
                _Pragma("unroll") for (int d0 = 0; d0 < 4; ++d0) dst_ = MFMA32(kfs[d0], qfs[d0], dst_); \
                SB(); } while (0)
#define EXPACK(sc_, rbq_, p0_, p1_) do { float ps_ = 0.f; \
                _Pragma("unroll") for (int r = 0; r < 16; ++r) { sc_[r] = __builtin_amdgcn_exp2f(SHIFT ? sc_[r] - bound2 : sc_[r]); ps_ += sc_[r]; } \
                lsum[rbq_] += ps_; p0_ = pack8(sc_, 0); p1_ = pack8(sc_, 1); } while (0)
#define BLOAD(B_, ks_) do { asm volatile("" : "+v"(v0l)); _Pragma("unroll") for (int cb = 0; cb < 4; ++cb) B_[cb] = BFRAG(ks_, cb); SB(); } while (0)
#define PVMMA(B_, pA_, pB_) do { _Pragma("unroll") for (int cb = 0; cb < 4; ++cb) { o[0][cb] = MFMA32(pA_, B_[cb], o[0][cb]); o[1][cb] = MFMA32(pB_, B_[cb], o[1][cb]); } } while (0)
            {
                f32x16 s0, s1; bf16x8 pa00, pa01, pa10, pa11; bf16x8 kfs[4], qfs[4];
                CHAIN(s0, 0, 0, true, true); CHAIN(s1, 0, 1, false, true);
                EXPACK(s0, 0, pa00, pa01); EXPACK(s1, 1, pa10, pa11);
                SB();
                CHAIN(s1, 1, 1, true, false); CHAIN(s0, 1, 0, false, true);
                bf16x8 pb00, pb01, pb10, pb11; bf16x8 B[4];
                BLOAD(B, 0);
                PVMMA(B, pa00, pa10); EXPACK(s0, 0, pb00, pb01);
                SB();
                BLOAD(B, 1);
                PVMMA(B, pa01, pa11); EXPACK(s1, 1, pb10, pb11);
                SB();
                BLOAD(B, 2);
                PVMMA(B, pb00, pb10);
                SB();
                BLOAD(B, 3);
                PVMMA(B, pb01, pb11);
                SB();
            }
#undef CHAIN
#undef EXPACK
#undef BLOAD
#undef PVMMA
#undef SB
#undef KFRAG
#undef QFRAG
#undef BFRAG
            asm volatile("s_waitcnt vmcnt(0)" ::: "memory");
            __syncthreads();
        }
#undef AT2_DMA
        lsum[0] += __shfl_xor(lsum[0], 32); lsum[1] += __shfl_xor(lsum[1], 32);
        int lanev = (int)__builtin_amdgcn_mbcnt_hi(~0u, __builtin_amdgcn_mbcnt_lo(~0u, 0u)); asm volatile("" : "+v"(lanev));
        const int hiv = lanev >> 5, l31v = lanev & 31;
        if (hiv == 0) { lscr[l31v] = lsum[0]; lscr[32 + l31v] = lsum[1]; }
        __syncthreads();
        bf16_t* obase = dry ? (bf16_t*)(p.ws + OFF_DUMMY) : (mix + qrow0 * MIXW);
        float lamv, lam_init;
        { const float* lp = p.lam + layer * 256; const float s1 = wave_sum(lp[lanev] * lp[64 + lanev]), s2 = wave_sum(lp[128 + lanev] * lp[192 + lanev]);
          lam_init = layer == 0 ? 0.2f : (layer == 1 ? 0.355509068f : (layer == 2 ? 0.470713018f : 0.556058204f));
          lamv = __uint_as_float(__builtin_amdgcn_readfirstlane(__float_as_uint(expf(s1) - expf(s2) + lam_init))); }
        float sw[4];
#pragma unroll
        for (int cb = 0; cb < 4; ++cb) sw[cb] = p.subln[layer * 128 + 32 * cb + l31v] * (1.0f - lam_init);
        LAS float* ex = (LAS float*)lds + qg * 4096;
#pragma unroll
        for (int rbq = 0; rbq < 2; ++rbq) {
#pragma unroll
            for (int r = 0; r < 16; ++r) { const float rl = __builtin_amdgcn_rcpf(lscr[32 * rbq + crow(r, hiv)]);
#pragma unroll
                for (int cb = 0; cb < 4; ++cb) o[rbq][cb][r] *= rl; }
            if (c == 1) {
#pragma unroll
                for (int cb = 0; cb < 4; ++cb)
#pragma unroll
                    for (int r = 0; r < 16; ++r) ex[crow(r, hiv) * 128 + 32 * cb + l31v] = o[rbq][cb][r];
            }
            __syncthreads();
            if (c == 0) {
                LAS unsigned char* stg = lds + AT2_QS + wave * 8192;
#pragma unroll
                for (int r = 0; r < 16; ++r) {
                    float a[4]; float ss = 0.f;
#pragma unroll
                    for (int cb = 0; cb < 4; ++cb) { a[cb] = o[rbq][cb][r] - lamv * ex[crow(r, hiv) * 128 + 32 * cb + l31v]; ss += a[cb] * a[cb]; }
                    ss = half_sum32(ss); const float ri = rsqrtf(ss * (1.0f / 128.0f) + EPSN);
                    LAS bf16_t* sp = (LAS bf16_t*)(stg + crow(r, hiv) * 256) + l31v;
#pragma unroll
                    for (int cb = 0; cb < 4; ++cb) sp[32 * cb] = f2bf1(a[cb] * ri * sw[cb]);
                }
                asm volatile("s_waitcnt lgkmcnt(0)" ::: "memory");
#pragma unroll
                for (int i = 0; i < 8; ++i) { const int q = lanev + 64 * i, row = q >> 4, ch = q & 15;
                    const u32x4 v = *(const LAS u32x4*)(stg + row * 256 + ch * 16);
                    *(u32x4*)(obase + (size_t)(64 * qg + 32 * rbq + row) * MIXW + h * 128 + ch * 8) = v; }
                asm volatile("s_waitcnt lgkmcnt(0)" ::: "memory");
            }
            __syncthreads();
        }
    }
    __syncthreads();
}

#ifndef PROBE_MASK
#define PROBE_MASK 0
#endif
#ifndef PROBE_GEMM
#define PROBE_GEMM 1
#endif
#ifndef PROBE_SYNC
#define PROBE_SYNC 1
#endif
#ifndef PH_MASK
#define PH_MASK 1023
#endif
constexpr int STEPS_PER_LAYER = 8, STEPS_PER_GROUP = 1 + DEPTH * STEPS_PER_LAYER, NSTEPS = 2 * STEPS_PER_GROUP;

__global__ void __launch_bounds__(NTHREADS, 2) mega_fwd(Params p_arg) {
    typedef const __attribute__((address_space(4))) Params* KArgP;
    extern __shared__ __attribute__((aligned(16))) unsigned char lds_raw[];
    LAS unsigned char* lds = (LAS unsigned char*)lds_raw;
    const int GRID = gridDim.x; const int bx = blockIdx.x; const int vcu = (GRID % 8 == 0) ? (bx % 8) * (GRID / 8) + bx / 8 : bx;
    const int NGW = GRID * NWAVES; const int wave0 = __builtin_amdgcn_readfirstlane((int)threadIdx.x >> 6);
    cg::grid_group grid = cg::this_grid();
    volatile LAS unsigned* xst = (volatile LAS unsigned*)(lds + LDS_BYTES - 64);
    if (threadIdx.x == 0) { xst[0] = 0u; xst[1] = 0u; }
    __syncthreads();
    const XcdBarrier xbar = xcd_barrier_post((unsigned*)(p_arg.ws + OFF_CTL), xst);
    const int step_lo = p_arg.step_lo, step_hi = p_arg.step_hi;
    int step_begin = step_lo;
    if (step_begin == 0 && step_hi > 0) {
        const Params p = p_arg;
        const int lane_i = (int)threadIdx.x & 63; const Grp G0 = grp_of(0);
        phase_prep_x(p.x_in[0], (bf16_t*)(p.ws + OFF_XBA), (float*)(p.ws + OFF_RSQ1), G0.M, bx * NWAVES + wave0, NGW, lane_i);
        phase_weights(p, lds, bx * NWAVES + wave0, NGW, wave0, lane_i);
        phase_trig(p, bx * NTHREADS + (int)threadIdx.x, GRID * NTHREADS);
        if (step_hi > 1) grid.sync();
        step_begin = 1;
    }
    for (int step = step_begin; step < step_hi; ++step) {
        KArgP kq = (KArgP)__builtin_amdgcn_kernarg_segment_ptr(); asm volatile("" : "+s"(kq));
        Params p;
        p.x_in[0] = kq->x_in[0]; p.x_in[1] = kq->x_in[1]; p.p_in[0] = kq->p_in[0]; p.p_in[1] = kq->p_in[1];
        p.ln1 = nullptr; p.w_in = nullptr; p.w_out = nullptr; p.ln2 = nullptr; p.w1 = nullptr; p.w2 = nullptr; p.wg = nullptr; p.wp = nullptr;
        p.qn = kq->qn; p.kn = kq->kn; p.lam = kq->lam; p.subln = kq->subln; p.decay = kq->decay; p.gn = kq->gn;
        p.out = kq->out; p.ws = kq->ws; p.step_lo = step_lo; p.step_hi = step_hi;
        int nrep = 1; { const int sg_ = step % STEPS_PER_GROUP; const int ph_ = sg_ > 0 ? (sg_ - 1) % STEPS_PER_LAYER : 8; nrep = ((PROBE_MASK >> ph_) & 1) ? 2 : 1; }
        _Pragma("nounroll") for (int rep = 0; rep < nrep; ++rep) {
        const int wave = wave0; const int gw = bx * NWAVES + wave;
#define FRESH_LANE int lane = (int)__builtin_amdgcn_mbcnt_hi(~0u, __builtin_amdgcn_mbcnt_lo(~0u, 0u)); asm volatile("" : "+v"(lane)); int tid = wave0 * 64 + lane; (void)tid;
        const int g = step / STEPS_PER_GROUP, sg = step % STEPS_PER_GROUP; const Grp G = grp_of(g);
        bf16_t* xbA = (bf16_t*)(p.ws + OFF_XBA); bf16_t* xbB = (bf16_t*)(p.ws + OFF_XBB);
        bf16_t* mix = (bf16_t*)(p.ws + OFF_BIG + BIG_MIX); bf16_t* rest = (bf16_t*)(p.ws + OFF_BIG + BIG_REST); bf16_t* hmid = (bf16_t*)(p.ws + OFF_BIG);
        bf16_t* ptmp = (bf16_t*)(p.ws + OFF_BIG); bf16_t* pb = (bf16_t*)(p.ws + OFF_PB);
        float* rsq1 = (float*)(p.ws + OFF_RSQ1); float* rsq2 = (float*)(p.ws + OFF_RSQ2);
        float* X = p.out + (size_t)G.tok0 * DM;
        if (sg == 0) {
            if (PH_MASK & 512) { FRESH_LANE phase_prep_x(p.x_in[1], xbA, rsq1, G.M, gw, NGW, lane); }
        } else {
            const int layer = (sg - 1) / STEPS_PER_LAYER, ph = (sg - 1) % STEPS_PER_LAYER; const bool dry = rep + 1 < nrep;
            bf16_t* xin_b = (layer & 1) ? xbB : xbA; bf16_t* xoth = (layer & 1) ? xbA : xbB;
            const bf16_t* wt = (const bf16_t*)(p.ws + OFF_WT) + (size_t)layer * WL_SIZE;
            if ((PH_MASK >> ph) & 1) switch (ph) {
            case 0: { FRESH_LANE pg8::Gemm gm{xin_b, wt + WL_IN, G.M, NIN, DM}; pg8::StaticOrder S; S.init(G.M, NIN, GRID, bx); EpiProj E{mix, rest, rsq1, p.qn + layer * 64, p.kn + layer * 64, (const float*)(p.ws + OFF_TRIGD), (const float*)(p.ws + OFF_TRIGR), G.S - 1, (const LAS float*)(lds + RINV_OFF), 0};
                      build_rinv(S, rsq1, (LAS float*)(lds + RINV_OFF), tid);
                      pg8::gemm_phase<EpiProj, pg8::StaticOrder, true, true>(lds, gm, S, E, tid); } break;
            case 1: { FRESH_LANE phase_ret_kv(p, G, layer, lds, tid, wave, lane); } break;
            case 2: { FRESH_LANE phase_ret_scan(p, G, layer, tid, dry); phase_pb(p, G, layer, g, gw, NGW, lane); } break;
            case 3:
#ifndef NO_ATTN
                { int lane1 = (int)__builtin_amdgcn_mbcnt_hi(~0u, __builtin_amdgcn_mbcnt_lo(~0u, 0u)); asm volatile("" : "+v"(lane1));
                  const float mqk = wave_max(fabsf(p.qn[layer * 64 + lane1])) * wave_max(fabsf(p.kn[layer * 64 + lane1]));
                  const bool need_shift = __builtin_amdgcn_readfirstlane((int)(8.0f * mqk * LOG2E > 60.0f)) != 0;
                  if (need_shift) { int la = (int)__builtin_amdgcn_mbcnt_hi(~0u, __builtin_amdgcn_mbcnt_lo(~0u, 0u)); asm volatile("" : "+v"(la)); phase_attn(p, G, layer, lds, wave * 64 + la, wave, la, vcu, dry); }
                  else { int lb = (int)__builtin_amdgcn_mbcnt_hi(~0u, __builtin_amdgcn_mbcnt_lo(~0u, 0u)); asm volatile("" : "+v"(lb)); phase_attn2<false>(p, G, layer, lds, wave * 64 + lb, wave, lb, vcu, dry); } }
#endif
#ifndef NO_RETOUT
                { int lane2 = (int)__builtin_amdgcn_mbcnt_hi(~0u, __builtin_amdgcn_mbcnt_lo(~0u, 0u)); asm volatile("" : "+v"(lane2)); phase_ret_out(p, G, layer, lds, wave * 64 + lane2, wave, lane2, dry); }
#endif
                break;
            case 4: { FRESH_LANE pg8::Gemm gm{mix, wt + WL_OUT, G.M, DM, DM}; pg8::StaticOrder S; S.init(G.M, DM, GRID, bx);
                      EpiResid E{nullptr, xin_b, xoth, rsq2};
                      pg8::gemm_phase<EpiResid, pg8::StaticOrder, true, true>(lds, gm, S, E, tid); } break;
            case 5: { FRESH_LANE pg8::Gemm gm{xoth, wt + WL_1, G.M, DFF, DM}; pg8::StaticOrder S; S.init(G.M, DFF, GRID, bx); EpiMlp1 E{hmid, rsq2, (const LAS float*)(lds + RINV_OFF), 0};
                      build_rinv(S, rsq2, (LAS float*)(lds + RINV_OFF), tid);
                      pg8::gemm_phase<EpiMlp1, pg8::StaticOrder, true, true>(lds, gm, S, E, tid); } break;
            case 6: { FRESH_LANE pg8::Gemm gm{hmid, wt + WL_2, G.M, DM, DFF}; pg8::StaticOrder S; S.init(G.M, DM, GRID, bx); EpiResid E{nullptr, xoth, xin_b, nullptr};
                      pg8::gemm_phase<EpiResid, pg8::StaticOrder, true, true>(lds, gm, S, E, tid); } break;
            case 7: { FRESH_LANE
#ifndef NO_GP
                      { int kp = PLE; asm volatile("" : "+s"(kp)); pg8::Gemm gm{pb, wt + WL_P, G.M, DM, kp}; pg8::StaticOrder S; S.init(G.M, DM, GRID, bx); EpiP E{ptmp};
                        pg8::gemm_phase<EpiP, pg8::StaticOrder, true, true>(lds, gm, S, E, tid); }
                      __syncthreads(); asm volatile("" : "+v"(tid));
#endif
#ifndef NO_GG
                      { pg8::Gemm gm{xin_b, wt + WL_G, G.M, DM, DM}; pg8::StaticOrder S; S.init(G.M, DM, GRID, bx); EpiGate E{xin_b, ptmp, xoth, rsq1, layer == DEPTH - 1 ? X : nullptr};
                        pg8::gemm_phase<EpiGate, pg8::StaticOrder, true, true>(lds, gm, S, E, tid); }
#endif
                    } break;
            }
        }
        }
        if (step + 1 < step_hi) {
            { for (int rep2 = 0; rep2 < PROBE_SYNC; ++rep2) { int t0 = wave0 * 64 + (int)__builtin_amdgcn_mbcnt_hi(~0u, __builtin_amdgcn_mbcnt_lo(~0u, 0u)); xcd_barrier(xbar, t0); } }
        }
    }
}

#ifndef PH_MASK_UNUSED
#endif
#ifndef MK_MULTI
#define MK_MULTI 0
#endif
extern "C" void kernel_launch(void* const* d_in, const int* in_sizes, int n_in, void* d_out, int out_size, void* d_ws, size_t ws_size, hipStream_t stream) {
    static int grid = 0;
    if (grid == 0) {
        if (n_in != 18 || ws_size < WS_NEED || out_size != 49152 * DM) { fprintf(stderr, "kernel_launch: unexpected sizes (n_in %d, ws %zu need %zu, out %d)\n", n_in, ws_size, (size_t)WS_NEED, out_size); grid = -1; return; }
        int dev = 0, cus = 0, per_cu = 0;
        hipGetDevice(&dev); hipDeviceGetAttribute(&cus, hipDeviceAttributeMultiprocessorCount, dev);
        if (hipFuncSetAttribute((const void*)mega_fwd, hipFuncAttributeMaxDynamicSharedMemorySize, LDS_BYTES) != hipSuccess) { fprintf(stderr, "kernel_launch: hipFuncSetAttribute failed\n"); grid = -1; return; }
        if (hipOccupancyMaxActiveBlocksPerMultiprocessor(&per_cu, (const void*)mega_fwd, NTHREADS, LDS_BYTES) != hipSuccess || per_cu < 1) { fprintf(stderr, "kernel_launch: occupancy query gave %d\n", per_cu); per_cu = 1; }
        (void)hipGetLastError();
        grid = cus * 1;
        fprintf(stderr, "kernel_launch: grid %d (per_cu %d), ws %zu need %zu\n", grid, per_cu, ws_size, (size_t)WS_NEED);
    }
    if (grid < 0) return;
    if (hipMemsetAsync((char*)d_ws + OFF_CTL, 0, CTL_BYTES, stream) != hipSuccess) { fprintf(stderr, "kernel_launch: memset failed\n"); return; }
    Params p{};
    p.x_in[0] = (const float*)d_in[0]; p.x_in[1] = (const float*)d_in[1]; p.p_in[0] = (const float*)d_in[2]; p.p_in[1] = (const float*)d_in[3];
    p.ln1 = (const float*)d_in[4]; p.w_in = (const float*)d_in[5]; p.qn = (const float*)d_in[6]; p.kn = (const float*)d_in[7]; p.lam = (const float*)d_in[8];
    p.subln = (const float*)d_in[9]; p.decay = (const float*)d_in[10]; p.gn = (const float*)d_in[11]; p.w_out = (const float*)d_in[12]; p.ln2 = (const float*)d_in[13];
    p.w1 = (const float*)d_in[14]; p.w2 = (const float*)d_in[15]; p.wg = (const float*)d_in[16]; p.wp = (const float*)d_in[17];
    p.out = (float*)d_out; p.ws = (unsigned char*)d_ws;
#if MK_MULTI
    for (int s = 0; s < NSTEPS; ++s) { p.step_lo = s; p.step_hi = s + 1; hipLaunchKernelGGL(mega_fwd, dim3(grid), dim3(NTHREADS), LDS_BYTES, stream, p); }
#else
    p.step_lo = 0; p.step_hi = NSTEPS;
    void* args[] = {&p};
    hipError_t e = hipLaunchCooperativeKernel((const void*)mega_fwd, dim3(grid), dim3(NTHREADS), args, LDS_BYTES, stream);
    if (e != hipSuccess) fprintf(stderr, "kernel_launch: cooperative launch failed: %s (grid %d)\n", hipGetErrorString(e), grid);
#endif
}
```

```cpp
#include <hip/hip_runtime.h>
#include <hip/hip_cooperative_groups.h>
#include <cstdio>
#include <cstdint>
namespace cg = cooperative_groups;
namespace pg8 {
#define PG8_LAS __attribute__((address_space(3)))
typedef unsigned short bf16_t;
typedef short bf16x8 __attribute__((ext_vector_type(8)));
typedef float f32x4 __attribute__((ext_vector_type(4)));
typedef unsigned u32x4 __attribute__((ext_vector_type(4)));
constexpr int BM = 256, BK = 64, HALF = 128, HTB = HALF * BK * 2  , STAGE_BYTES = 8 * HTB, NXCD = 8, WGM = 8;

__host__ __device__ __forceinline__ int lds_byte(int r, int c) { const int st = (r >> 4) * 2 + (c >> 5), rr = r & 15, cc = c & 31, ob = rr * 64 + cc * 2; return st * 1024 + (ob ^ (((ob >> 9) & 1) << 5)); }
__host__ __device__ __forceinline__ void stage_rc(int b, int& R, int& C) { const int st = b / 1024, sb = b % 1024, swz = sb ^ (((sb >> 9) & 1) << 5); R = (st >> 1) * 16 + swz / 64; C = (st & 1) * 32 + (swz % 64) / 2; }
__host__ __device__ __forceinline__ int perm32(int rho) { const int n = rho >> 4, i = rho & 15; return 8 * (i >> 2) + 4 * n + (i & 3); }

struct Unit { int pm, pn; };
struct Gemm { const bf16_t* A; const bf16_t* Bt; int M, N, K; };

struct StaticOrder {
    int nM, nN, nwg, G, c;
    __host__ __device__ void init(int M, int N, int G_, int c_) { nM = M / BM; nN = N / BM; nwg = nM * nN; G = G_; c = c_; }
    __host__ __device__ bool next(int i, Unit& u) const {
        const long L = (long)i * G + c; if (L >= nwg) return false;
        int wgid = (int)L; { const int q = nwg / NXCD, r = nwg % NXCD, xcd = wgid % NXCD, off = wgid / NXCD; wgid = (xcd < r ? xcd * (q + 1) : r * (q + 1) + (xcd - r) * q) + off; }
        const int nig = WGM * nN, gid = wgid / nig, fm = gid * WGM, gsz = (nM - fm) < WGM ? (nM - fm) : WGM;
        u.pm = fm + ((wgid % nig) % gsz); u.pn = (wgid % nig) / gsz; return true;
    }
    __device__ __forceinline__ void a_ready(const Unit&) const {}
    __device__ __forceinline__ void done(const Unit&) const {}
};

__device__ __forceinline__ unsigned cvt_pk_bf16(float lo, float hi) { unsigned r; asm volatile("v_cvt_pk_bf16_f32 %0, %1, %2" : "=v"(r) : "v"(lo), "v"(hi)); return r; }
template <class Epi, class Sched, bool ALIGN_EPI = false, bool SP2 = false>
__device__ __forceinline__ void gemm_phase(PG8_LAS unsigned char* lds, const Gemm g, const Sched& S, const Epi& E, const int tid) {
    const int wid = __builtin_amdgcn_readfirstlane(tid >> 6), lane = tid & 63, wr = wid >> 2, wc = wid & 3, fr = lane & 15, fq = lane >> 4;
    const int K = g.K, nt = K / BK;
    unsigned voffA[2], voffB[2];
#pragma unroll
    for (int i = 0; i < 2; ++i) { int R, C; stage_rc(tid * 16 + i * 8192, R, C); const int Rb = Epi::PERM ? ((R & ~31) + perm32(R & 31)) : R;
        voffA[i] = (unsigned)(R * K + C) * 2u; voffB[i] = (unsigned)(Rb * K + C) * 2u; }
    const size_t kstep = (size_t)(BK * 2);
    const size_t hstep = (size_t)HALF * K * 2;
    const size_t tstep = 2 * hstep;
    const unsigned ldsw = (unsigned)wid * 1024u;
    const int aoff = lds_byte(wr * 64 + fr, fq * 8), boff = lds_byte(wc * 32 + fr, fq * 8);
#define PG8_SA(b, h) (((b) * 2 + (h)) * HTB)
#define PG8_SB(b, h) ((4 + (b) * 2 + (h)) * HTB)
#define PG8_STAGE(bufoff, gbase, voff) do { _Pragma("unroll") for (int _i = 0; _i < 2; ++_i) \
        __builtin_amdgcn_global_load_lds((const unsigned*)((const char*)(gbase) + (voff)[_i]), (PG8_LAS unsigned*)(lds + (bufoff) + ldsw + _i * 8192), 16, 0, 0); } while (0)
#define PG8_LDA(dst, b, h) do { _Pragma("unroll") for (int m = 0; m < 4; ++m) _Pragma("unroll") for (int k = 0; k < 2; ++k) dst[m][k] = *(const PG8_LAS bf16x8*)(lds + PG8_SA(b, h) + aoff + m * 2048 + k * 1024); } while (0)
#define PG8_LDB(dst, b, h) do { _Pragma("unroll") for (int n = 0; n < 2; ++n) _Pragma("unroll") for (int k = 0; k < 2; ++k) dst[n][k] = *(const PG8_LAS bf16x8*)(lds + PG8_SB(b, h) + boff + n * 2048 + k * 1024); } while (0)
#define PG8_MMA(ai, bj, At, Bt) do { __builtin_amdgcn_s_setprio(1); _Pragma("unroll") for (int m = 0; m < 4; ++m) _Pragma("unroll") for (int n = 0; n < 2; ++n) _Pragma("unroll") for (int k = 0; k < 2; ++k) \
        acc[ai][bj][m][n] = __builtin_amdgcn_mfma_f32_16x16x32_bf16(Bt[n][k], At[m][k], acc[ai][bj][m][n], 0, 0, 0); __builtin_amdgcn_s_setprio(0); } while (0)
#define PG8_WAIT_V(n) asm volatile("s_waitcnt vmcnt(" #n ")" ::: "memory")
#define PG8_WAIT_L(n) asm volatile("s_waitcnt lgkmcnt(" #n ")" ::: "memory")
#define PG8_BAR __builtin_amdgcn_s_barrier()
#define PG8_SCHED __builtin_amdgcn_sched_barrier(0)
    Unit cur, nxt; int ui = 0;
    if (!S.next(0, cur)) return;
    f32x4 acc[2][2][4][2];
#pragma unroll
    for (int a = 0; a < 2; ++a)
#pragma unroll
        for (int b = 0; b < 2; ++b)
#pragma unroll
            for (int m = 0; m < 4; ++m)
#pragma unroll
                for (int n = 0; n < 2; ++n) acc[a][b][m][n] = (f32x4){0.f, 0.f, 0.f, 0.f};
    bf16x8 At[4][2], B0[2][2], B1[2][2];
    const char* cA = (const char*)g.A + (size_t)cur.pm * tstep; const char* cB = (const char*)g.Bt + (size_t)cur.pn * tstep;
    S.a_ready(cur);
    if constexpr (SP2) {
        PG8_STAGE(PG8_SB(0, 0), cB, voffB); PG8_STAGE(PG8_SB(0, 1), cB + hstep, voffB); PG8_STAGE(PG8_SA(0, 0), cA, voffA); PG8_STAGE(PG8_SA(0, 1), cA + hstep, voffA);
        if (wr == 1) PG8_BAR;
        PG8_WAIT_V(2); PG8_BAR;
        PG8_STAGE(PG8_SB(1, 0), cB + kstep, voffB); PG8_STAGE(PG8_SA(1, 0), cA + kstep, voffA); PG8_STAGE(PG8_SB(1, 1), cB + hstep + kstep, voffB);
        PG8_WAIT_V(6); PG8_BAR;
    } else {
        PG8_STAGE(PG8_SB(0, 0), cB, voffB); PG8_STAGE(PG8_SA(0, 0), cA, voffA); PG8_STAGE(PG8_SB(0, 1), cB + hstep, voffB); PG8_STAGE(PG8_SA(0, 1), cA + hstep, voffA);
        if (wr == 1) PG8_BAR;
        PG8_WAIT_V(4); PG8_BAR;
        PG8_STAGE(PG8_SB(1, 0), cB + kstep, voffB); PG8_STAGE(PG8_SA(1, 0), cA + kstep, voffA); PG8_STAGE(PG8_SB(1, 1), cB + hstep + kstep, voffB);
        PG8_WAIT_V(6); PG8_BAR;
    }
    for (;;) {
        const bool has_next = S.next(ui + 1, nxt);
        const char* nA = has_next ? (const char*)g.A + (size_t)nxt.pm * tstep : cA; const char* nB = has_next ? (const char*)g.Bt + (size_t)nxt.pn * tstep : cB;
        for (int t = 0; t < nt; t += 2) {
            const bool last = (t == nt - 2);
            const char* a1 = cA + (size_t)(t + 1) * kstep;
            const char* a2 = last ? nA : cA + (size_t)(t + 2) * kstep; const char* b2 = last ? nB : cB + (size_t)(t + 2) * kstep;
            const char* a3 = a2 + kstep; const char* b3 = b2 + kstep;
            if (last && has_next) S.a_ready(nxt);
            if constexpr (SP2) {
            PG8_LDB(B0, 0, 0); PG8_LDB(B1, 0, 1); PG8_SCHED; PG8_LDA(At, 0, 0); PG8_STAGE(PG8_SA(1, 1), a1 + hstep, voffA);
            PG8_WAIT_V(8); PG8_WAIT_L(0); PG8_BAR; PG8_MMA(0, 0, At, B0); PG8_MMA(0, 1, At, B1); PG8_BAR; PG8_SCHED;
            PG8_LDA(At, 0, 1); PG8_STAGE(PG8_SB(0, 0), b2, voffB); PG8_STAGE(PG8_SB(0, 1), b2 + hstep, voffB); PG8_STAGE(PG8_SA(0, 0), a2, voffA);
            PG8_WAIT_V(8); PG8_WAIT_L(0); PG8_BAR; PG8_MMA(1, 0, At, B0); PG8_MMA(1, 1, At, B1); PG8_BAR; PG8_SCHED;
            PG8_LDB(B0, 1, 0); PG8_LDB(B1, 1, 1); PG8_SCHED; PG8_LDA(At, 1, 0); PG8_STAGE(PG8_SA(0, 1), a2 + hstep, voffA);
            PG8_WAIT_V(8); PG8_WAIT_L(0); PG8_BAR; PG8_MMA(0, 0, At, B0); PG8_MMA(0, 1, At, B1); PG8_BAR; PG8_SCHED;
            PG8_LDA(At, 1, 1); PG8_STAGE(PG8_SB(1, 0), b3, voffB); PG8_STAGE(PG8_SB(1, 1), b3 + hstep, voffB); PG8_STAGE(PG8_SA(1, 0), a3, voffA);
            PG8_WAIT_V(8); PG8_WAIT_L(0); PG8_BAR; PG8_MMA(1, 0, At, B0); PG8_MMA(1, 1, At, B1); PG8_BAR; PG8_SCHED;
            } else {
            PG8_LDB(B0, 0, 0); PG8_SCHED; PG8_LDA(At, 0, 0); PG8_STAGE(PG8_SA(1, 1), a1 + hstep, voffA);
            PG8_WAIT_L(8); PG8_BAR; PG8_WAIT_L(0); PG8_MMA(0, 0, At, B0); PG8_BAR; PG8_SCHED;
            PG8_LDB(B1, 0, 1); PG8_STAGE(PG8_SB(0, 0), b2, voffB);
            PG8_BAR; PG8_WAIT_L(0); PG8_MMA(0, 1, At, B1); PG8_BAR;
            PG8_LDA(At, 0, 1); PG8_STAGE(PG8_SA(0, 0), a2, voffA);
            PG8_BAR; PG8_WAIT_L(0); PG8_MMA(1, 0, At, B0); PG8_BAR; PG8_SCHED;
            PG8_STAGE(PG8_SB(0, 1), b2 + hstep, voffB);
            PG8_WAIT_V(6); PG8_BAR; PG8_MMA(1, 1, At, B1); PG8_BAR;
            PG8_LDB(B0, 1, 0); PG8_SCHED; PG8_LDA(At, 1, 0); PG8_STAGE(PG8_SA(0, 1), a2 + hstep, voffA);
            PG8_WAIT_L(8); PG8_BAR; PG8_WAIT_L(0); PG8_MMA(0, 0, At, B0); PG8_BAR; PG8_SCHED;
            PG8_LDB(B1, 1, 1); PG8_STAGE(PG8_SB(1, 0), b3, voffB);
            PG8_BAR; PG8_WAIT_L(0); PG8_MMA(0, 1, At, B1); PG8_BAR;
            PG8_LDA(At, 1, 1); PG8_STAGE(PG8_SA(1, 0), a3, voffA);
            PG8_BAR; PG8_WAIT_L(0); PG8_MMA(1, 0, At, B0); PG8_BAR; PG8_SCHED;
            PG8_STAGE(PG8_SB(1, 1), b3 + hstep, voffB);
            PG8_WAIT_V(6); PG8_BAR; PG8_MMA(1, 1, At, B1); PG8_BAR;
            }
        }
        if constexpr (ALIGN_EPI) { if (wr == 0) PG8_BAR; }
        if constexpr (!Epi::AFTER_DRAIN) { E(acc, cur, wr, wc, fr, fq); S.done(cur); }
        if (!has_next) break;
#pragma unroll
        for (int a = 0; a < 2; ++a)
#pragma unroll
            for (int b = 0; b < 2; ++b)
#pragma unroll
                for (int m = 0; m < 4; ++m)
#pragma unroll
                    for (int n = 0; n < 2; ++n) acc[a][b][m][n] = (f32x4){0.f, 0.f, 0.f, 0.f};
        cur = nxt; cA = nA; cB = nB; ++ui;
        if constexpr (ALIGN_EPI) { if (wr == 1) PG8_BAR; }
    }
    PG8_WAIT_V(0);
    if constexpr (!ALIGN_EPI) { if (wr == 0) PG8_BAR; }
    PG8_BAR;
    if constexpr (Epi::AFTER_DRAIN) { E.fused(acc, cur, wr, wc, fr, fq, lds, wid, lane); S.done(cur); }
#undef PG8_SA
#undef PG8_SB
#undef PG8_STAGE
#undef PG8_LDA
#undef PG8_LDB
#undef PG8_MMA
#undef PG8_WAIT_V
#undef PG8_WAIT_L
#undef PG8_BAR
#undef PG8_SCHED
}
}
#define DI __device__ __forceinline__
#define LAS __attribute__((address_space(3)))
typedef unsigned short bf16_t;
typedef short bf16x8 __attribute__((ext_vector_type(8)));
typedef short s16x4 __attribute__((ext_vector_type(4)));
typedef float f32x4 __attribute__((ext_vector_type(4)));
typedef float f32x16 __attribute__((ext_vector_type(16)));
typedef unsigned u32x4 __attribute__((ext_vector_type(4)));
typedef unsigned u32x2 __attribute__((ext_vector_type(2)));

constexpr int DM = 1024, NIN = 3584, DFF = 4096, PLE = 256, DEPTH = 4;
constexpr int MIXW = 1024, RESTW = 2560;
constexpr int R_DK = 0, R_DV = 512, R_RK = 1024, R_RV = 1536, R_RG = 2048;
constexpr float EPSN = 1e-6f;
constexpr float LOG2E = 1.4426950408889634f;
constexpr int NTHREADS = 512, NWAVES = 8;
constexpr int LDS_BYTES = 147456;
constexpr int MAXM = 32768;

constexpr size_t WL_IN = 0, WL_OUT = WL_IN + (size_t)NIN * DM, WL_1 = WL_OUT + (size_t)DM * DM, WL_2 = WL_1 + (size_t)DFF * DM,
                 WL_G = WL_2 + (size_t)DM * DFF, WL_P = WL_G + (size_t)DM * DM, WL_SIZE = WL_P + (size_t)DM * PLE;
constexpr size_t OFF_WT = 0;
constexpr size_t OFF_XBA = OFF_WT + WL_SIZE * 2 * DEPTH;
constexpr size_t OFF_XBB = OFF_XBA + (size_t)MAXM * DM * 2;
constexpr size_t OFF_BIG = OFF_XBB + (size_t)MAXM * DM * 2;
constexpr size_t BIG_MIX = 0, BIG_REST = (size_t)MAXM * MIXW * 2, BIG_ST = BIG_REST + (size_t)MAXM * RESTW * 2;
constexpr size_t BIG_SIZE = BIG_ST + (size_t)(MAXM / 128) * 8 * 2 * 4096 * 4;
constexpr size_t OFF_PB = OFF_BIG + BIG_SIZE;
constexpr size_t OFF_RSQ1 = OFF_PB + (size_t)MAXM * PLE * 2;
constexpr size_t OFF_RSQ2 = OFF_RSQ1 + (size_t)MAXM * 16 * 4;
constexpr size_t OFF_ST16 = OFF_RSQ2 + (size_t)MAXM * 16 * 4;
constexpr size_t OFF_CTL = OFF_ST16 + (size_t)(MAXM / 128) * 8 * 2 * 4096 * 2;
constexpr size_t CTL_BYTES = 16384;
constexpr size_t OFF_TRIGR = OFF_CTL + 65536;
constexpr size_t OFF_TRIGD = OFF_TRIGR + (size_t)8192 * 64 * 4;
constexpr size_t OFF_DUMMY = OFF_TRIGD + (size_t)8192 * 16 * 4;
constexpr size_t WS_NEED = OFF_DUMMY + (1u << 20);
static_assert((size_t)MAXM * DFF * 2 <= BIG_SIZE, "hmid overlays proj + states");

__device__ const float ROT_D[8] = {1.f, 0.193922758f, 0.0376060307f, 0.00729266508f, 0.00141421345f, 0.000274248188f, 5.31829646e-05f, 1.03133852e-05f};
__device__ const float ROT_R[32] = {1.f, 0.749894202f, 0.562341332f, 0.421696514f, 0.316227764f, 0.237137392f, 0.177827939f, 0.133352146f, 0.100000001f, 0.0749894157f, 0.0562341288f, 0.0421696492f, 0.0316227786f, 0.0237137359f, 0.0177827943f, 0.0133352149f, 0.00999999978f, 0.00749894232f, 0.00562341325f, 0.00421696482f, 0.00316227786f, 0.00237137382f, 0.00177827943f, 0.00133352145f, 0.00100000005f, 0.000749894185f, 0.000562341302f, 0.000421696546f, 0.000316227786f, 0.000237137385f, 0.00017782794f, 0.00013335215f};

struct Params {
    const float* x_in[2]; const float* p_in[2];
    const float *ln1, *w_in, *qn, *kn, *lam, *subln, *decay, *gn, *w_out, *ln2, *w1, *w2, *wg, *wp;
    float* out; unsigned char* ws;
    int step_lo, step_hi;
};

DI unsigned pk2(float lo, float hi) { typedef float f2 __attribute__((ext_vector_type(2))); typedef __bf16 b2 __attribute__((ext_vector_type(2))); f2 v = {lo, hi}; b2 b = __builtin_convertvector(v, b2); return __builtin_bit_cast(unsigned, b); }
DI float bf_lo(unsigned w) { return __uint_as_float(w << 16); }
DI float bf_hi(unsigned w) { return __uint_as_float(w & 0xffff0000u); }
DI float bf1(bf16_t h) { return __uint_as_float(((unsigned)h) << 16); }
DI bf16_t f2bf1(float f) { return (bf16_t)(pk2(f, 0.f) & 0xffffu); }
DI int crow(int r, int hi) { return (r & 3) + 8 * (r >> 2) + 4 * hi; }
DI float wave_sum(float v) {
#pragma unroll
    for (int o = 1; o < 64; o <<= 1) v += __shfl_xor(v, o);
    return v;
}
DI float wave_max(float v) {
#pragma unroll
    for (int o = 1; o < 64; o <<= 1) v = fmaxf(v, __shfl_xor(v, o));
    return v;
}
DI float half_sum32(float v) {
#pragma unroll
    for (int o = 1; o < 32; o <<= 1) v += __shfl_xor(v, o);
    return v;
}
DI s16x4 vtr(const LAS unsigned char* p) { typedef short v4i16_t __attribute__((ext_vector_type(4))); return __builtin_bit_cast(s16x4, __builtin_amdgcn_ds_read_tr16_b64_v4i16((LAS v4i16_t*)p)); }
DI bf16x8 cat8(s16x4 lo, s16x4 hi) { return (bf16x8){lo[0], lo[1], lo[2], lo[3], hi[0], hi[1], hi[2], hi[3]}; }
#define MFMA32(a, b, c) __builtin_amdgcn_mfma_f32_32x32x16_bf16((a), (b), (c), 0, 0, 0)
DI bf16x8 pack8(const f32x16& x, int s) {
    u32x4 p; p.x = pk2(x[8 * s], x[8 * s + 1]); p.y = pk2(x[8 * s + 2], x[8 * s + 3]); p.z = pk2(x[8 * s + 4], x[8 * s + 5]); p.w = pk2(x[8 * s + 6], x[8 * s + 7]);
    return __builtin_bit_cast(bf16x8, p);
}
DI float rowscale(const float* rsq, int row) {
    const f32x4* p = (const f32x4*)(rsq + (size_t)row * 16);
    f32x4 a = p[0], b = p[1], c = p[2], d = p[3];
    float s = ((a.x + a.y) + (a.z + a.w)) + ((b.x + b.y) + (b.z + b.w)) + ((c.x + c.y) + (c.z + c.w)) + ((d.x + d.y) + (d.z + d.w));
    return rsqrtf(s * (1.0f / DM) + EPSN);
}

constexpr int RINV_OFF = 131072, RINV_SLOTS = 8;
using pg8::Unit; using pg8::BM; using pg8::HALF; using pg8::cvt_pk_bf16;
DI int pi_diff(int s) { return s < 8 ? s : (s < 32 ? s + 8 : (s < 40 ? s - 24 : s)); }
struct EpiProj {
    static constexpr bool PERM = true, AFTER_DRAIN = false;
    bf16_t* mix; bf16_t* rest; const float* rsq; const float* qnw; const float* knw; const float* trigD; const float* trigR; int smask; const LAS float* rtab; mutable int ui;
    DI void operator()(const f32x4 (&acc)[2][2][4][2], const Unit& u, int wr, int wc, int fr, int fq) const {
        const int row0 = u.pm * BM + wr * 64 + fr; const int type = u.pn >> 1; const int slot = ui++; const LAS float* rt = rtab + slot * 256 + wr * 64 + fr;
        bf16_t* base; int ld, colt;
        if (u.pn < 4) { base = mix; ld = MIXW; colt = u.pn * BM; } else { base = rest; ld = RESTW; colt = (u.pn - 4) * BM; }
        const int col0 = colt + 64 * wc + 8 * fq;
        const bool isnorm = (type == 0) || (type == 2), isrot = (type == 1) || (type == 4);
        const float osc = type == 0 ? (0.125f * LOG2E) : (type == 4 ? 0.125f : 1.0f);
        f32x4 w[2][2];
        if (isnorm) { const float* wp = type == 0 ? qnw : knw;
#pragma unroll
            for (int bj = 0; bj < 2; ++bj)
#pragma unroll
                for (int n = 0; n < 2; ++n)
#pragma unroll
                    for (int j = 0; j < 4; ++j) w[bj][n][j] = wp[pi_diff(32 * bj + 8 * fq + 4 * n + j)]; }
#pragma unroll
        for (int ai = 0; ai < 2; ++ai)
#pragma unroll
            for (int m = 0; m < 4; ++m) {
                const int row = row0 + ai * HALF + m * 16; const float ri = slot < RINV_SLOTS ? rt[ai * HALF + m * 16] : rowscale(rsq, row); const int pos = row & smask;
                f32x4 v[2][2];
#pragma unroll
                for (int bj = 0; bj < 2; ++bj)
#pragma unroll
                    for (int n = 0; n < 2; ++n) v[bj][n] = acc[ai][bj][m][n] * ri;
                if (isnorm) {
                    float ss = 0.f;
#pragma unroll
                    for (int bj = 0; bj < 2; ++bj)
#pragma unroll
                        for (int n = 0; n < 2; ++n) ss += (v[bj][n][0] * v[bj][n][0] + v[bj][n][1] * v[bj][n][1]) + (v[bj][n][2] * v[bj][n][2] + v[bj][n][3] * v[bj][n][3]);
                    ss += __shfl_xor(ss, 16); ss += __shfl_xor(ss, 32);
                    const float rn = rsqrtf(ss * (1.0f / 64.0f) + EPSN);
#pragma unroll
                    for (int bj = 0; bj < 2; ++bj)
#pragma unroll
                        for (int n = 0; n < 2; ++n) v[bj][n] = v[bj][n] * rn * w[bj][n];
                    if (fq == 0) { const float* t = trigD + (size_t)pos * 16;
#pragma unroll
                        for (int n = 0; n < 2; ++n) { const f32x4 c4 = *(const f32x4*)(t + 4 * n), s4 = *(const f32x4*)(t + 8 + 4 * n); const f32x4 x1 = v[0][n], x2 = v[1][n];
                            v[0][n] = x1 * c4 - x2 * s4; v[1][n] = x1 * s4 + x2 * c4; } }
                } else if (isrot) { const float* t = trigR + (size_t)pos * 64 + 8 * fq;
#pragma unroll
                    for (int n = 0; n < 2; ++n) { const f32x4 c4 = *(const f32x4*)(t + 4 * n), s4 = *(const f32x4*)(t + 32 + 4 * n); const f32x4 x1 = v[0][n], x2 = v[1][n];
                        v[0][n] = x1 * c4 - x2 * s4; v[1][n] = x1 * s4 + x2 * c4; }
                }
                bf16_t* rowp = base + (size_t)row * ld + col0;
#pragma unroll
                for (int bj = 0; bj < 2; ++bj) { const f32x4 v0 = v[bj][0] * osc, v1 = v[bj][1] * osc;
                    u32x4 o; o.x = pk2(v0[0], v0[1]); o.y = pk2(v0[2], v0[3]); o.z = pk2(v1[0], v1[1]); o.w = pk2(v1[2], v1[3]);
                    *(u32x4*)(rowp + 32 * bj) = o; }
            }
    }
};
struct EpiMlp1 {
    static constexpr bool PERM = true, AFTER_DRAIN = false;
    bf16_t* O; const float* rsq; const LAS float* rtab; mutable int ui;
    DI void operator()(const f32x4 (&acc)[2][2][4][2], const Unit& u, int wr, int wc, int fr, int fq) const {
        const int row0 = u.pm * BM + wr * 64 + fr; const int col0 = u.pn * BM + wc * 32 + 8 * fq; const int slot = ui++; const LAS float* rt = rtab + slot * 256 + wr * 64 + fr;
#pragma unroll
        for (int ai = 0; ai < 2; ++ai)
#pragma unroll
            for (int m = 0; m < 4; ++m) {
                const int row = row0 + ai * HALF + m * 16; const float ri = slot < RINV_SLOTS ? rt[ai * HALF + m * 16] : rowscale(rsq, row);
                bf16_t* rowp = O + (size_t)row * DFF + col0;
#pragma unroll
                for (int bj = 0; bj < 2; ++bj) { f32x4 v0 = acc[ai][bj][m][0] * ri, v1 = acc[ai][bj][m][1] * ri;
#pragma unroll
                    for (int j = 0; j < 4; ++j) { float a = fmaxf(v0[j], 0.f), b = fmaxf(v1[j], 0.f); v0[j] = a * a; v1[j] = b * b; }
                    u32x4 w; w.x = pk2(v0[0], v0[1]); w.y = pk2(v0[2], v0[3]); w.z = pk2(v1[0], v1[1]); w.w = pk2(v1[2], v1[3]);
                    *(u32x4*)(rowp + bj * HALF) = w; }
            }
    }
};
struct EpiP {
    static constexpr bool PERM = true, AFTER_DRAIN = false;
    bf16_t* O;
    DI void operator()(const f32x4 (&acc)[2][2][4][2], const Unit& u, int wr, int wc, int fr, int fq) const {
        const int row0 = u.pm * BM + wr * 64 + fr; const int col0 = u.pn * BM + wc * 32 + 8 * fq;
#pragma unroll
        for (int ai = 0; ai < 2; ++ai)
#pragma unroll
            for (int m = 0; m < 4; ++m) { bf16_t* rowp = O + (size_t)(row0 + ai * HALF + m * 16) * DM + col0;
#pragma unroll
                for (int bj = 0; bj < 2; ++bj) { const f32x4 v0 = acc[ai][bj][m][0], v1 = acc[ai][bj][m][1];
                    u32x4 w; w.x = pk2(v0[0], v0[1]); w.y = pk2(v0[2], v0[3]); w.z = pk2(v1[0], v1[1]); w.w = pk2(v1[2], v1[3]); *(u32x4*)(rowp + bj * HALF) = w; } }
    }
};
struct EpiResid {
    static constexpr bool PERM = true, AFTER_DRAIN = false;
    const float* xf; const bf16_t* xh; bf16_t* xb; float* rsq;
    DI void operator()(const f32x4 (&acc)[2][2][4][2], const Unit& u, int wr, int wc, int fr, int fq) const {
        const int row0 = u.pm * BM + wr * 64 + fr; const int col0 = u.pn * BM + wc * 32 + 8 * fq;
        if (xf) {
#pragma unroll
            for (int ai = 0; ai < 2; ++ai) { f32x4 xv[4][2][2];
#pragma unroll
                for (int m = 0; m < 4; ++m)
#pragma unroll
                    for (int bj = 0; bj < 2; ++bj) { const size_t o = (size_t)(row0 + ai * HALF + m * 16) * DM + col0 + bj * HALF; xv[m][bj][0] = *(const f32x4*)(xf + o); xv[m][bj][1] = *(const f32x4*)(xf + o + 4); }
                asm volatile("" ::: "memory");
#pragma unroll
                for (int m = 0; m < 4; ++m) { const int row = row0 + ai * HALF + m * 16; const size_t off = (size_t)row * DM + col0; float ss = 0.f;
#pragma unroll
                    for (int bj = 0; bj < 2; ++bj) { const size_t o = off + bj * HALF; const f32x4 v0 = xv[m][bj][0] + acc[ai][bj][m][0], v1 = xv[m][bj][1] + acc[ai][bj][m][1];
                        u32x4 w; w.x = pk2(v0[0], v0[1]); w.y = pk2(v0[2], v0[3]); w.z = pk2(v1[0], v1[1]); w.w = pk2(v1[2], v1[3]); *(u32x4*)(xb + o) = w;
                        ss += ((v0[0] * v0[0] + v0[1] * v0[1]) + (v0[2] * v0[2] + v0[3] * v0[3])) + ((v1[0] * v1[0] + v1[1] * v1[1]) + (v1[2] * v1[2] + v1[3] * v1[3])); }
                    if (rsq) { ss += __shfl_xor(ss, 16); ss += __shfl_xor(ss, 32); if (fq == 0) rsq[(size_t)row * 16 + u.pn * 4 + wc] = ss; } }
                asm volatile("" ::: "memory"); }
        } else {
            u32x4 hv[2][4][2];
#pragma unroll
            for (int ai = 0; ai < 2; ++ai)
#pragma unroll
                for (int m = 0; m < 4; ++m)
#pragma unroll
                    for (int bj = 0; bj < 2; ++bj) hv[ai][m][bj] = *(const u32x4*)(xh + (size_t)(row0 + ai * HALF + m * 16) * DM + col0 + bj * HALF);
            asm volatile("" ::: "memory");
#pragma unroll
            for (int ai = 0; ai < 2; ++ai)
#pragma unroll
                for (int m = 0; m < 4; ++m) { const int row = row0 + ai * HALF + m * 16; const size_t off = (size_t)row * DM + col0; float ss = 0.f;
#pragma unroll
                    for (int bj = 0; bj < 2; ++bj) { const size_t o = off + bj * HALF; const u32x4 h = hv[ai][m][bj];
                        const f32x4 v0 = (f32x4){bf_lo(h.x), bf_hi(h.x), bf_lo(h.y), bf_hi(h.y)} + acc[ai][bj][m][0], v1 = (f32x4){bf_lo(h.z), bf_hi(h.z), bf_lo(h.w), bf_hi(h.w)} + acc[ai][bj][m][1];
                        u32x4 w; w.x = pk2(v0[0], v0[1]); w.y = pk2(v0[2], v0[3]); w.z = pk2(v1[0], v1[1]); w.w = pk2(v1[2], v1[3]); *(u32x4*)(xb + o) = w;
                        ss += ((v0[0] * v0[0] + v0[1] * v0[1]) + (v0[2] * v0[2] + v0[3] * v0[3])) + ((v1[0] * v1[0] + v1[1] * v1[1]) + (v1[2] * v1[2] + v1[3] * v1[3])); }
                    if (rsq) { ss += __shfl_xor(ss, 16); ss += __shfl_xor(ss, 32); if (fq == 0) rsq[(size_t)row * 16 + u.pn * 4 + wc] = ss; } }
        }
    }
};
struct EpiGate {
    static constexpr bool PERM = true, AFTER_DRAIN = false;
    const bf16_t* xh; const bf16_t* P; bf16_t* xb; float* rsq; float* yout;
    DI void operator()(const f32x4 (&acc)[2][2][4][2], const Unit& u, int wr, int wc, int fr, int fq) const {
        const int row0 = u.pm * BM + wr * 64 + fr; const int col0 = u.pn * BM + wc * 32 + 8 * fq;
#pragma unroll
        for (int ai = 0; ai < 2; ++ai) {
            u32x4 pv[4][2], hv[4][2];
#pragma unroll
            for (int m = 0; m < 4; ++m)
#pragma unroll
                for (int bj = 0; bj < 2; ++bj) { const size_t o = (size_t)(row0 + ai * HALF + m * 16) * DM + col0 + bj * HALF; pv[m][bj] = *(const u32x4*)(P + o); hv[m][bj] = *(const u32x4*)(xh + o); }
            asm volatile("" ::: "memory");
#pragma unroll
            for (int m = 0; m < 4; ++m) { const int row = row0 + ai * HALF + m * 16; const size_t off = (size_t)row * DM + col0; float ss = 0.f;
#pragma unroll
                for (int bj = 0; bj < 2; ++bj) { const size_t o = off + bj * HALF; const f32x4 g0 = acc[ai][bj][m][0], g1 = acc[ai][bj][m][1]; const u32x4 pw = pv[m][bj]; const u32x4 h = hv[m][bj];
                    f32x4 v0 = (f32x4){bf_lo(h.x), bf_hi(h.x), bf_lo(h.y), bf_hi(h.y)}, v1 = (f32x4){bf_lo(h.z), bf_hi(h.z), bf_lo(h.w), bf_hi(h.w)};
                    v0[0] += bf_lo(pw.x) * __builtin_amdgcn_rcpf(1.f + __expf(-g0[0])); v0[1] += bf_hi(pw.x) * __builtin_amdgcn_rcpf(1.f + __expf(-g0[1]));
                    v0[2] += bf_lo(pw.y) * __builtin_amdgcn_rcpf(1.f + __expf(-g0[2])); v0[3] += bf_hi(pw.y) * __builtin_amdgcn_rcpf(1.f + __expf(-g0[3]));
                    v1[0] += bf_lo(pw.z) * __builtin_amdgcn_rcpf(1.f + __expf(-g1[0])); v1[1] += bf_hi(pw.z) * __builtin_amdgcn_rcpf(1.f + __expf(-g1[1]));
                    v1[2] += bf_lo(pw.w) * __builtin_amdgcn_rcpf(1.f + __expf(-g1[2])); v1[3] += bf_hi(pw.w) * __builtin_amdgcn_rcpf(1.f + __expf(-g1[3]));
                    if (yout) { *(f32x4*)(yout + o) = v0; *(f32x4*)(yout + o + 4) = v1; }
                    u32x4 w; w.x = pk2(v0[0], v0[1]); w.y = pk2(v0[2], v0[3]); w.z = pk2(v1[0], v1[1]); w.w = pk2(v1[2], v1[3]); *(u32x4*)(xb + o) = w;
                    ss += ((v0[0] * v0[0] + v0[1] * v0[1]) + (v0[2] * v0[2] + v0[3] * v0[3])) + ((v1[0] * v1[0] + v1[1] * v1[1]) + (v1[2] * v1[2] + v1[3] * v1[3])); }
                ss += __shfl_xor(ss, 16); ss += __shfl_xor(ss, 32); if (fq == 0) rsq[(size_t)row * 16 + u.pn * 4 + wc] = ss; }
            asm volatile("" ::: "memory");
        }
    }
};

DI void build_rinv(const pg8::StaticOrder& S, const float* rsq, LAS float* tab, int tid) {
    const int r = tid & 255;
#pragma unroll 1
    for (int i = tid >> 8; i < RINV_SLOTS; i += 2) { Unit u; if (!S.next(i, u)) break; tab[i * 256 + r] = rowscale(rsq, u.pm * BM + r); }
    __syncthreads();
}
#define XB_TMO      128
#define XB_XCNT(j)  (256  + 64 * (j))
#define XB_XSUB(j)  (1280 + 64 * (j))
#define XB_XGEN(j)  (2304 + 64 * (j))
#define XB_TOP      3328
#define XB_TOPGEN   3392
#define XCD_BAR_WORDS 3456
#define XB_SPIN_CAP (1u << 18)

__device__ __forceinline__ unsigned xb_ld(unsigned* p)              { return __hip_atomic_load(p, __ATOMIC_RELAXED, __HIP_MEMORY_SCOPE_AGENT); }
__device__ __forceinline__ unsigned xb_add(unsigned* p, unsigned v) { return __hip_atomic_fetch_add(p, v, __ATOMIC_RELAXED, __HIP_MEMORY_SCOPE_AGENT); }
__device__ __forceinline__ unsigned xb_xcc_id() { return (unsigned)__builtin_amdgcn_s_getreg((3 << 11) | 20) & 0xFu; }
#define XB_SPIN(cond, bar) do { unsigned _sp = 0; while (cond) { __builtin_amdgcn_s_sleep(1); \
    if ((++_sp & 255u) == 0u) { if (xb_ld(&(bar)[XB_TMO])) break; if (_sp > XB_SPIN_CAP) { atomicAdd(&(bar)[XB_TMO], 1u); break; } } } } while (0)

struct XcdBarrier {
    unsigned* bar; unsigned x;
    volatile LAS unsigned* st;
};

__device__ __forceinline__ XcdBarrier xcd_barrier_post(unsigned* bar, volatile LAS unsigned* st) {
    XcdBarrier b; b.bar = bar; b.x = xb_xcc_id(); b.st = st;
    if (threadIdx.x == 0) (void)xb_add(&bar[XB_XCNT(b.x)], 1u);
    return b;
}
__device__ __forceinline__ void xcd_barrier_complete(unsigned* bar, unsigned x, unsigned& nloc, unsigned& nx) {
    const unsigned G = gridDim.x * gridDim.y * gridDim.z;
    unsigned sum, cnt, mine, sp = 0u;
    for (;;) {
        sum = 0u; cnt = 0u; mine = 0u;
#pragma unroll
        for (unsigned j = 0; j < 16; ++j) { const unsigned c = xb_ld(&bar[XB_XCNT(j)]); sum += c; cnt += (c > 0u) ? 1u : 0u; mine = (j == x) ? c : mine; }
        if (sum == G) break;
        __builtin_amdgcn_s_sleep(1);
        if ((++sp & 255u) == 0u) { if (xb_ld(&bar[XB_TMO])) break; if (sp > XB_SPIN_CAP) { atomicAdd(&bar[XB_TMO], 1u); break; } }
    }
    nloc = mine > 0u ? mine : 1u; nx = cnt > 0u ? cnt : 1u;
}

__device__ __forceinline__ void xcd_barrier(const XcdBarrier& b, const int tid) {
    asm volatile("s_waitcnt vmcnt(0)" ::: "memory");
    __syncthreads();
    if (tid == 0) {
        unsigned* bar = b.bar;
        __builtin_amdgcn_s_waitcnt(0);
        unsigned nloc = b.st[0], nx = b.st[1];
        if (nloc == 0u) { xcd_barrier_complete(bar, b.x, nloc, nx); b.st[0] = nloc; b.st[1] = nx; }
        const unsigned old = xb_add(&bar[XB_XSUB(b.x)], 1u);
        const unsigned gen = old / nloc;
        if (old + 1u == (gen + 1u) * nloc) {
            __builtin_amdgcn_fence(__ATOMIC_RELEASE, "agent");
            asm volatile("s_waitcnt vmcnt(0)" ::: "memory");
            const unsigned og = xb_add(&bar[XB_TOP], 1u);
            const unsigned tg = og / nx;
            if (og + 1u == (tg + 1u) * nx) xb_add(&bar[XB_TOPGEN], 1u);
            else XB_SPIN(xb_ld(&bar[XB_TOPGEN]) == tg, bar);
            __builtin_amdgcn_fence(__ATOMIC_ACQUIRE, "agent");
            xb_add(&bar[XB_XGEN(b.x)], 1u);
            asm volatile("s_waitcnt vmcnt(0)" ::: "memory");
        } else {
            XB_SPIN(xb_ld(&bar[XB_XGEN(b.x)]) == gen, bar);
            __builtin_amdgcn_fence(__ATOMIC_ACQUIRE, "agent");
            asm volatile("s_waitcnt vmcnt(0)" ::: "memory");
        }
    }
    __syncthreads();
}

struct Grp { int NB, S, M, tok0; };
DI Grp grp_of(int g) { Grp G; if (g == 0) { G.NB = 2; G.S = 8192; G.M = 16384; G.tok0 = 0; } else { G.NB = 8; G.S = 4096; G.M = 32768; G.tok0 = 16384; } return G; }

DI int remap_in(int n) {
    const int blk = n >> 9, r = n & 511; const int ob = (blk == 0) ? 0 : (blk == 1) ? 3 : (blk == 2) ? 1 : (blk == 3) ? 2 : blk; return ob * 512 + r;
}
DI int win_src_col(int n) {
    const int pn = n >> 8, r = n & 255, bj = r >> 7, wc = (r >> 5) & 3, off = r & 31; int s = 32 * bj + off;
    if (pn == 0 || pn == 1 || pn == 4 || pn == 5) s = pi_diff(s);
    return remap_in(256 * pn + 64 * wc + s);
}
DI void transpose_item(const float* W, int K, int N, bf16_t* WT, const float* kscale, bool remap, LAS float* scr, int item, int lane) {
    const int nblk = N / 64, kb = item / nblk, nb = item % nblk, k0 = 64 * kb, n0 = 64 * nb; const int cg = lane & 15;
    const int scol = remap ? win_src_col(n0 + 4 * cg) : n0 + 4 * cg;
#pragma unroll 8
    for (int i = 0; i < 16; ++i) { const int kk = 4 * i + (lane >> 4); f32x4 v = *(const f32x4*)(W + (size_t)(k0 + kk) * N + scol); if (kscale) v = v * kscale[k0 + kk];
        LAS float* d = scr + kk * 65 + 4 * cg; d[0] = v[0]; d[1] = v[1]; d[2] = v[2]; d[3] = v[3]; }
    asm volatile("s_waitcnt lgkmcnt(0)" ::: "memory");
    const int c = lane & 7;
#pragma unroll
    for (int j = 0; j < 8; ++j) { const int n = (lane >> 3) + 8 * j; const LAS float* s = scr + (8 * c) * 65 + n;
        u32x4 o; o.x = pk2(s[0 * 65], s[1 * 65]); o.y = pk2(s[2 * 65], s[3 * 65]); o.z = pk2(s[4 * 65], s[5 * 65]); o.w = pk2(s[6 * 65], s[7 * 65]);
        *(u32x4*)(WT + (size_t)(n0 + n) * K + k0 + 8 * c) = o; }
    asm volatile("s_waitcnt lgkmcnt(0)" ::: "memory");
}
DI void phase_weights(const Params& p, LAS unsigned char* lds, int gw, int NGW, int wave, int lane) {
    LAS float* scr = (LAS float*)(lds + wave * 16896);
    constexpr int I_IN = (DM / 64) * (NIN / 64), I_OUT = (DM / 64) * (DM / 64), I_1 = (DM / 64) * (DFF / 64), I_2 = (DFF / 64) * (DM / 64), I_G = I_OUT, I_P = (PLE / 64) * (DM / 64);
    constexpr int PER_L = I_IN + I_OUT + I_1 + I_2 + I_G + I_P;
    for (int it = gw; it < PER_L * DEPTH; it += NGW) {
        const int L = it / PER_L; int r = it % PER_L;
        bf16_t* wt = (bf16_t*)(p.ws + OFF_WT) + (size_t)L * WL_SIZE;
        if (r < I_IN) { transpose_item(p.w_in + (size_t)L * DM * NIN, DM, NIN, wt + WL_IN, p.ln1 + L * DM, true, scr, r, lane); continue; } r -= I_IN;
        if (r < I_OUT) { transpose_item(p.w_out + (size_t)L * DM * DM, DM, DM, wt + WL_OUT, nullptr, false, scr, r, lane); continue; } r -= I_OUT;
        if (r < I_1) { transpose_item(p.w1 + (size_t)L * DM * DFF, DM, DFF, wt + WL_1, p.ln2 + L * DM, false, scr, r, lane); continue; } r -= I_1;
        if (r < I_2) { transpose_item(p.w2 + (size_t)L * DFF * DM, DFF, DM, wt + WL_2, nullptr, false, scr, r, lane); continue; } r -= I_2;
        if (r < I_G) { transpose_item(p.wg + (size_t)L * DM * DM, DM, DM, wt + WL_G, nullptr, false, scr, r, lane); continue; } r -= I_G;
        transpose_item(p.wp + (size_t)L * PLE * DM, PLE, DM, wt + WL_P, nullptr, false, scr, r, lane);
    }
}
DI void phase_prep_x(const float* x, bf16_t* xb, float* rsq, int M, int gw, int NGW, int lane) {
    for (int m = gw; m < M; m += NGW) {
        const f32x4* xr = (const f32x4*)(x + (size_t)m * DM) + lane; u32x2* o = (u32x2*)(xb + (size_t)m * DM) + lane; float s = 0.f;
#pragma unroll
        for (int j = 0; j < 4; ++j) { const f32x4 v = xr[64 * j]; s += (v.x * v.x + v.y * v.y) + (v.z * v.z + v.w * v.w); u32x2 w; w.x = pk2(v.x, v.y); w.y = pk2(v.z, v.w); o[64 * j] = w; }
        s = wave_sum(s);
        if (lane < 16) rsq[(size_t)m * 16 + lane] = (lane == 0) ? s : 0.f;
    }
}
DI void sincos_rev(float ang, float& s, float& c) {
    double rev = (double)ang * 0.15915494309189535; rev -= __builtin_rint(rev); const float fr = (float)rev;
    s = __builtin_amdgcn_sinf(fr); c = __builtin_amdgcn_cosf(fr);
}
DI void phase_trig(const Params& p, int gthread, int nthreads) {
    float* tr = (float*)(p.ws + OFF_TRIGR); float* td = (float*)(p.ws + OFF_TRIGD);
    for (int i = gthread; i < 8192 * 40; i += nthreads) { const int pos = i / 40, f = i % 40; float sn, cs;
        if (f < 32) { sincos_rev((float)pos * ROT_R[f], sn, cs); tr[(size_t)pos * 64 + f] = cs; tr[(size_t)pos * 64 + 32 + f] = sn; }
        else { sincos_rev((float)pos * ROT_D[f - 32], sn, cs); td[(size_t)pos * 16 + (f - 32)] = cs; td[(size_t)pos * 16 + 8 + (f - 32)] = sn; } }
}
DI void phase_pb(const Params& p, const Grp& G, int layer, int g, int gw, int NGW, int lane) {
    bf16_t* pb = (bf16_t*)(p.ws + OFF_PB); const float* pin = (g ? p.p_in[1] : p.p_in[0]) + (size_t)layer * G.M * PLE;
    for (int m = gw; m < G.M; m += NGW) { const f32x4 v = *((const f32x4*)(pin + (size_t)m * PLE) + lane); u32x2 w; w.x = pk2(v.x, v.y); w.y = pk2(v.z, v.w); *((u32x2*)(pb + (size_t)m * PLE) + lane) = w; }
}
DI void rot_token(const Params& p, int layer, float pos, int l8, const float (&qw)[8], const float (&kw)[8], const u32x4 (&win)[4], u32x4 (&wout)[4]) {
    float cd[8], sd[8];
    if (l8 < 2) {
#pragma unroll
        for (int e = 0; e < 8; ++e) sincos_rev(pos * ROT_D[e], sd[e], cd[e]);
    } else {
#pragma unroll
        for (int e = 0; e < 8; ++e) { sd[e] = 0.f; cd[e] = 1.f; }
    }
#pragma unroll
    for (int which = 0; which < 2; ++which) {
        const u32x4 w = win[which]; float v[8] = {bf_lo(w.x), bf_hi(w.x), bf_lo(w.y), bf_hi(w.y), bf_lo(w.z), bf_hi(w.z), bf_lo(w.w), bf_hi(w.w)};
        float ss = 0.f;
#pragma unroll
        for (int e = 0; e < 8; ++e) ss += v[e] * v[e];
        ss += __shfl_xor(ss, 1); ss += __shfl_xor(ss, 2); ss += __shfl_xor(ss, 4);
        const float ri = rsqrtf(ss * (1.0f / 64.0f) + EPSN);
#pragma unroll
        for (int e = 0; e < 8; ++e) v[e] = v[e] * ri * (which == 0 ? qw[e] : kw[e]);
        float o[8];
#pragma unroll
        for (int e = 0; e < 8; ++e) { const float pr = __shfl_xor(v[e], 1);
            o[e] = (l8 == 0) ? (v[e] * cd[e] - pr * sd[e]) : (l8 == 1) ? (pr * sd[e] + v[e] * cd[e]) : v[e]; }
        const float sc = which == 0 ? (0.125f * LOG2E) : 1.0f;
        u32x4 r; r.x = pk2(o[0] * sc, o[1] * sc); r.y = pk2(o[2] * sc, o[3] * sc); r.z = pk2(o[4] * sc, o[5] * sc); r.w = pk2(o[6] * sc, o[7] * sc);
        wout[which] = r;
    }
    float cr[8], sr[8];
#pragma unroll
    for (int e = 0; e < 8; ++e) sincos_rev(pos * ROT_R[(l8 & 3) * 8 + e], sr[e], cr[e]);
#pragma unroll
    for (int which = 0; which < 2; ++which) {
        const u32x4 w = win[2 + which]; float v[8] = {bf_lo(w.x), bf_hi(w.x), bf_lo(w.y), bf_hi(w.y), bf_lo(w.z), bf_hi(w.z), bf_lo(w.w), bf_hi(w.w)};
        float o[8];
#pragma unroll
        for (int e = 0; e < 8; ++e) { const float pr = __shfl_xor(v[e], 4);
            o[e] = (l8 < 4) ? (v[e] * cr[e] - pr * sr[e]) : (pr * sr[e] + v[e] * cr[e]); }
        const float sc = which == 0 ? 1.0f : 0.125f;
        u32x4 r; r.x = pk2(o[0] * sc, o[1] * sc); r.y = pk2(o[2] * sc, o[3] * sc); r.z = pk2(o[4] * sc, o[5] * sc); r.w = pk2(o[6] * sc, o[7] * sc);
        wout[2 + which] = r;
    }
}
DI void phase_rot(const Params& p, const Grp& G, int layer, int g, int gw, int NGW, int lane, bool dry) {
    bf16_t* mix = (bf16_t*)(p.ws + OFF_BIG + BIG_MIX); bf16_t* rest = (bf16_t*)(p.ws + OFF_BIG + BIG_REST); bf16_t* pb = (bf16_t*)(p.ws + OFF_PB);
    bf16_t* omix = dry ? (bf16_t*)(p.ws + OFF_DUMMY) : mix; bf16_t* orest = dry ? (bf16_t*)(p.ws + OFF_DUMMY) : rest; const size_t omask = dry ? 63 : ~(size_t)0;
    const float* pin = (g ? p.p_in[1] : p.p_in[0]) + (size_t)layer * G.M * PLE;
    const int l8 = lane & 7, d0 = l8 * 8;
    float qw[8], kw[8];
#pragma unroll
    for (int e = 0; e < 8; ++e) { qw[e] = p.qn[layer * 64 + d0 + e]; kw[e] = p.kn[layer * 64 + d0 + e]; }
    for (int m0 = gw; m0 < G.M; m0 += 2 * NGW) {
        u32x4 win[2][4], wout[2][4]; f32x4 pv[2];
#pragma unroll
        for (int t = 0; t < 2; ++t) { const size_t m = (size_t)m0 + (size_t)t * NGW;
            win[t][0] = *(const u32x4*)(mix + m * MIXW + lane * 8); win[t][1] = *(const u32x4*)(rest + m * RESTW + R_DK + lane * 8);
            win[t][2] = *(const u32x4*)(mix + m * MIXW + 512 + lane * 8); win[t][3] = *(const u32x4*)(rest + m * RESTW + R_RK + lane * 8);
            pv[t] = *((const f32x4*)(pin + m * PLE) + lane); }
#pragma unroll
        for (int t = 0; t < 2; ++t) { const size_t m = (size_t)m0 + (size_t)t * NGW;
            rot_token(p, layer, (float)((int)m % G.S), l8, qw, kw, win[t], wout[t]);
            const size_t mo = m & omask;
            *(u32x4*)(omix + mo * MIXW + lane * 8) = wout[t][0]; *(u32x4*)(orest + mo * RESTW + R_DK + lane * 8) = wout[t][1];
            *(u32x4*)(omix + mo * MIXW + 512 + lane * 8) = wout[t][2]; *(u32x4*)(orest + mo * RESTW + R_RK + lane * 8) = wout[t][3];
            u32x2 w; w.x = pk2(pv[t].x, pv[t].y); w.y = pk2(pv[t].z, pv[t].w); *((u32x2*)(pb + m * PLE) + lane) = w; }
    }
}
DI float log2_gamma(const float* decay, int layer, int dir, int head) {
    const float xl = decay[layer * 16 + dir * 8 + head]; return -log1pf(expf(-xl)) * LOG2E;
}
constexpr int RP = 272;
DI void phase_ret_kv(const Params& p, const Grp& G, int layer, LAS unsigned char* lds, int tid, int wave, int lane) {
    const bf16_t* rest = (const bf16_t*)(p.ws + OFF_BIG + BIG_REST); bf16_t* ST = (bf16_t*)(p.ws + OFF_ST16);
    const int NC = G.S / 128, nunits = G.NB * NC * 4;
    LAS unsigned char* Kt = lds; LAS unsigned char* Vf = lds + 128 * RP; LAS unsigned char* Vb = lds + 2 * 128 * RP;
    const int hh = wave >> 2, ti = (wave >> 1) & 1, tj = wave & 1, hi = lane >> 5, q4 = (lane & 15) >> 2, p4 = lane & 3, blk = (lane >> 4) & 1;
    u32x4 pk[4], pv[4];
#define R1_ISSUE(u_) do { const int hp_ = (u_) & 3, c_ = ((u_) >> 2) % NC, b_ = ((u_) >> 2) / NC; const size_t r0_ = (size_t)b_ * G.S + (size_t)c_ * 128; \
        int tv_ = tid; asm volatile("" : "+v"(tv_)); \
        _Pragma("unroll") for (int i = 0; i < 4; ++i) { const int q = tv_ + 512 * i, row = q >> 4, ch = q & 15; const bf16_t* src = rest + (r0_ + row) * RESTW + hp_ * 128 + ch * 8; \
            pk[i] = *(const u32x4*)(src + R_RK); pv[i] = *(const u32x4*)(src + R_RV); } } while (0)
    if ((int)blockIdx.x < nunits) R1_ISSUE((int)blockIdx.x);
    for (int u = blockIdx.x; u < nunits; u += gridDim.x) {
        const int hp = u & 3, c = (u >> 2) % NC, b = (u >> 2) / NC;
        const float lgf_s = log2_gamma(p.decay, layer, 0, 2 * hp + ((tid & 15) >> 3)), lgb_s = log2_gamma(p.decay, layer, 1, 2 * hp + ((tid & 15) >> 3));
        __syncthreads();
#pragma unroll
        for (int i = 0; i < 4; ++i) { const int q = tid + 512 * i, row = q >> 4, ch = q & 15;
            const u32x4 kv = pk[i]; const u32x4 vv = pv[i];
            *(LAS u32x4*)(Kt + row * RP + ch * 16) = kv;
            const float df = __builtin_amdgcn_exp2f(lgf_s * (float)(127 - row)), db = __builtin_amdgcn_exp2f(lgb_s * (float)row);
            u32x4 a, bb;
            a.x = pk2(bf_lo(vv.x) * df, bf_hi(vv.x) * df); a.y = pk2(bf_lo(vv.y) * df, bf_hi(vv.y) * df); a.z = pk2(bf_lo(vv.z) * df, bf_hi(vv.z) * df); a.w = pk2(bf_lo(vv.w) * df, bf_hi(vv.w) * df);
            bb.x = pk2(bf_lo(vv.x) * db, bf_hi(vv.x) * db); bb.y = pk2(bf_lo(vv.y) * db, bf_hi(vv.y) * db); bb.z = pk2(bf_lo(vv.z) * db, bf_hi(vv.z) * db); bb.w = pk2(bf_lo(vv.w) * db, bf_hi(vv.w) * db);
            *(LAS u32x4*)(Vf + row * RP + ch * 16) = a; *(LAS u32x4*)(Vb + row * RP + ch * 16) = bb; }
        if (u + (int)gridDim.x < nunits) R1_ISSUE(u + (int)gridDim.x);
        __syncthreads();
        f32x16 af = {}, ab = {};
#pragma unroll
        for (int s = 0; s < 8; ++s) {
            const int rowa = (16 * s + 8 * hi + q4) * RP;
            const int cola = (hh * 64 + 32 * ti + 16 * blk + 4 * p4) * 2, colb = (hh * 64 + 32 * tj + 16 * blk + 4 * p4) * 2;
            const bf16x8 A = cat8(vtr(Kt + rowa + cola), vtr(Kt + rowa + 4 * RP + cola));
            const bf16x8 Bf = cat8(vtr(Vf + rowa + colb), vtr(Vf + rowa + 4 * RP + colb));
            const bf16x8 Bb = cat8(vtr(Vb + rowa + colb), vtr(Vb + rowa + 4 * RP + colb));
            af = MFMA32(A, Bf, af); ab = MFMA32(A, Bb, ab);
        }
        __syncthreads();
        { LAS bf16_t* img = (LAS bf16_t*)lds + hh * 8192;
#pragma unroll
          for (int r = 0; r < 16; ++r) { const int i = 32 * ti + crow(r, hi), j = 32 * tj + (lane & 31); img[i * 64 + j] = f2bf1(af[r]); img[4096 + i * 64 + j] = f2bf1(ab[r]); } }
        __syncthreads();
#pragma unroll
        for (int i = 0; i < 4; ++i) { const int q = tid + 512 * i, h2 = q >> 10, w = q & 1023;
            *(u32x4*)(ST + ((size_t)((b * 8 + 2 * hp + h2) * NC + c) * 2) * 4096 + w * 8) = *(const LAS u32x4*)((LAS bf16_t*)lds + h2 * 8192 + w * 8); }
    }
#undef R1_ISSUE
}
DI void phase_ret_scan(const Params& p, const Grp& G, int layer, int tid, bool dry) {
    bf16_t* S16 = (bf16_t*)(p.ws + OFF_ST16); const int NC = G.S / 128; const int total = G.NB * 8 * 2 * 512;
    for (int t = blockIdx.x * NTHREADS + tid; t < total; t += gridDim.x * NTHREADS) {
        const int e = (t & 511) * 8, dir = (t >> 9) & 1, bh = t >> 10, head = bh & 7;
        const float cd = __builtin_amdgcn_exp2f(log2_gamma(p.decay, layer, dir, head) * 128.0f);
        bf16_t* base = S16 + ((size_t)bh * NC * 2 + dir) * 4096 + e; float run[8];
#pragma unroll
        for (int k = 0; k < 8; ++k) run[k] = 0.f;
#define SCAN_STEP(idx_) do { const u32x4 kv_ = kvv[idx_]; u32x4 w_; w_.x = pk2(run[0], run[1]); w_.y = pk2(run[2], run[3]); w_.z = pk2(run[4], run[5]); w_.w = pk2(run[6], run[7]); \
            *(u32x4*)(base + (size_t)(c0 + (idx_)) * 8192) = w_; \
            run[0] = run[0] * cd + bf_lo(kv_.x); run[1] = run[1] * cd + bf_hi(kv_.x); run[2] = run[2] * cd + bf_lo(kv_.y); run[3] = run[3] * cd + bf_hi(kv_.y); \
            run[4] = run[4] * cd + bf_lo(kv_.z); run[5] = run[5] * cd + bf_hi(kv_.z); run[6] = run[6] * cd + bf_lo(kv_.w); run[7] = run[7] * cd + bf_hi(kv_.w); } while (0)
        if (dir == 0) {
            for (int c0 = 0; c0 < NC; c0 += 8) { u32x4 kvv[8];
#pragma unroll
                for (int i = 0; i < 8; ++i) kvv[i] = *(const u32x4*)(base + (size_t)(c0 + i) * 8192);
#pragma unroll
                for (int i = 0; i < 8; ++i) SCAN_STEP(i); }
        } else {
            for (int c0 = NC - 8; c0 >= 0; c0 -= 8) { u32x4 kvv[8];
#pragma unroll
                for (int i = 0; i < 8; ++i) kvv[i] = *(const u32x4*)(base + (size_t)(c0 + i) * 8192);
#pragma unroll
                for (int i = 7; i >= 0; --i) SCAN_STEP(i); }
        }
#undef SCAN_STEP
    }
}
constexpr int R3_S = 2 * 128 * RP;
DI void phase_ret_out(const Params& p, const Grp& G, int layer, LAS unsigned char* lds, int tid, int wave, int lane, bool dry) {
    bf16_t* mix = (bf16_t*)(p.ws + OFF_BIG + BIG_MIX); const bf16_t* rest = (const bf16_t*)(p.ws + OFF_BIG + BIG_REST); const bf16_t* ST = (const bf16_t*)(p.ws + OFF_ST16);
    const int NC = G.S / 128, nunits = G.NB * NC * 4;
    LAS unsigned char* Kt = lds; LAS unsigned char* Vt = lds + 128 * RP; LAS bf16_t* Sl = (LAS bf16_t*)(lds + R3_S);
    const int hh = wave >> 2, qg = wave & 3, hi = lane >> 5, l31 = lane & 31, q4 = (lane & 15) >> 2, p4 = lane & 3, blk = (lane >> 4) & 1;
    u32x4 pk[4], pv[4], ps[4];
#define R3_ISSUE(u_) do { const int hp_ = (u_) & 3, c_ = ((u_) >> 2) % NC, b_ = ((u_) >> 2) / NC; const size_t r0_ = (size_t)b_ * G.S + (size_t)c_ * 128; \
        int tv_ = tid; asm volatile("" : "+v"(tv_)); \
        _Pragma("unroll") for (int i = 0; i < 4; ++i) { const int q = tv_ + 512 * i, row = q >> 4, ch = q & 15; const bf16_t* src = rest + (r0_ + row) * RESTW + hp_ * 128 + ch * 8; \
            pk[i] = *(const u32x4*)(src + R_RK); pv[i] = *(const u32x4*)(src + R_RV); } \
        _Pragma("unroll") for (int i = 0; i < 4; ++i) { const int q = tv_ + 512 * i, h2 = q >> 10, w = q & 1023; \
            ps[i] = *(const u32x4*)(ST + ((size_t)((b_ * 8 + 2 * hp_ + h2) * NC + c_) * 2) * 4096 + w * 8); } } while (0)
    if ((int)blockIdx.x < nunits) R3_ISSUE((int)blockIdx.x);
    for (int u = blockIdx.x; u < nunits; u += gridDim.x) {
        const int hp = u & 3, c = (u >> 2) % NC, b = (u >> 2) / NC; const size_t row0 = (size_t)b * G.S + (size_t)c * 128; const int head = 2 * hp + hh;
        __syncthreads();
        int tidv = tid; asm volatile("" : "+v"(tidv));
#pragma unroll
        for (int i = 0; i < 4; ++i) { const int q = tidv + 512 * i, row = q >> 4, ch = q & 15;
            *(LAS u32x4*)(Kt + row * RP + ch * 16) = pk[i]; *(LAS u32x4*)(Vt + row * RP + ch * 16) = pv[i]; }
#pragma unroll
        for (int i = 0; i < 4; ++i) { const int q = tidv + 512 * i, h2 = q >> 10, w = q & 1023; *(LAS u32x4*)(Sl + h2 * 8192 + w * 8) = ps[i]; }
        bf16x8 qf[4];
        { const bf16_t* qp = mix + (row0 + 32 * qg + l31) * MIXW + 512 + head * 64 + 8 * hi;
#pragma unroll
          for (int d0 = 0; d0 < 4; ++d0) qf[d0] = *(const bf16x8*)(qp + 16 * d0); }
        u32x4 gwv[4];
        { int lv0 = lane; asm volatile("" : "+v"(lv0)); const bf16_t* gb0 = rest + (row0 + 32 * qg) * RESTW + R_RG + head * 64;
#pragma unroll
          for (int i = 0; i < 4; ++i) { const int q = lv0 + 64 * i; gwv[i] = *(const u32x4*)(gb0 + (size_t)(q >> 3) * RESTW + (q & 7) * 8); } }
        if (u + (int)gridDim.x < nunits) R3_ISSUE(u + (int)gridDim.x);
        const float lgf = log2_gamma(p.decay, layer, 0, head), lgb = log2_gamma(p.decay, layer, 1, head);
        __syncthreads();
        f32x16 o[2]; o[0] = f32x16{}; o[1] = f32x16{};
        const int nl = 32 * qg + l31;
#pragma unroll 1
        for (int rb = 0; rb < 4; ++rb) {
            f32x16 sacc = {};
#pragma unroll
            for (int d0 = 0; d0 < 4; ++d0) { const bf16x8 A = *(const LAS bf16x8*)(Kt + (32 * rb + l31) * RP + (hh * 64 + 16 * d0 + 8 * hi) * 2); sacc = MFMA32(A, qf[d0], sacc); }
#pragma unroll
            for (int r = 0; r < 16; ++r) { const int mloc = 32 * rb + crow(r, hi); const int df = nl - mloc; const float D = df >= 0 ? __builtin_amdgcn_exp2f(lgf * (float)df) : __builtin_amdgcn_exp2f(lgb * (float)(-df)); sacc[r] *= D; }
#pragma unroll
            for (int s2 = 0; s2 < 2; ++s2) { const bf16x8 A = pack8(sacc, s2); const int rowa = (32 * rb + 16 * s2 + 4 * hi + q4) * RP;
#pragma unroll
                for (int cb = 0; cb < 2; ++cb) { const int colb = (hh * 64 + 32 * cb + 16 * blk + 4 * p4) * 2;
                    const bf16x8 B = cat8(vtr(Vt + rowa + colb), vtr(Vt + rowa + 8 * RP + colb)); o[cb] = MFMA32(A, B, o[cb]); } }
        }
#pragma unroll 1
        for (int dir = 0; dir < 2; ++dir) {
            const LAS bf16_t* S = Sl + (hh * 2 + dir) * 4096; f32x16 t[2]; t[0] = f32x16{}; t[1] = f32x16{};
#pragma unroll
            for (int ks = 0; ks < 4; ++ks) {
#pragma unroll
                for (int cb = 0; cb < 2; ++cb) { const LAS bf16_t* sp = S + (16 * ks + 8 * hi) * 64 + 32 * cb + l31;
                    u32x4 w; w.x = (unsigned)sp[0] | ((unsigned)sp[64] << 16); w.y = (unsigned)sp[128] | ((unsigned)sp[192] << 16); w.z = (unsigned)sp[256] | ((unsigned)sp[320] << 16); w.w = (unsigned)sp[384] | ((unsigned)sp[448] << 16);
                    t[cb] = MFMA32(qf[ks], __builtin_bit_cast(bf16x8, w), t[cb]); }
                asm volatile("" ::: "memory"); }
#pragma unroll
            for (int r = 0; r < 16; ++r) { const int nrow = 32 * qg + crow(r, hi); const float sc = dir == 0 ? __builtin_amdgcn_exp2f(lgf * (float)(nrow + 1)) : __builtin_amdgcn_exp2f(lgb * (float)(128 - nrow));
                o[0][r] += t[0][r] * sc; o[1][r] += t[1][r] * sc; }
        }
        const float g0 = p.gn[layer * 64 + l31], g1 = p.gn[layer * 64 + 32 + l31];
        __syncthreads();
        LAS float* stg = (LAS float*)(lds + wave * 8192);
#pragma unroll
        for (int r = 0; r < 16; ++r) {
            float ss = o[0][r] * o[0][r] + o[1][r] * o[1][r]; ss = half_sum32(ss); const float ri = rsqrtf(ss * (1.0f / 64.0f) + EPSN);
            LAS float* sp = stg + crow(r, hi) * 64 + l31; sp[0] = o[0][r] * ri * g0; sp[32] = o[1][r] * ri * g1;
        }
        asm volatile("s_waitcnt lgkmcnt(0)" ::: "memory");
        { int lv = lane; asm volatile("" : "+v"(lv));
          bf16_t* ob = (dry ? (bf16_t*)(p.ws + OFF_DUMMY) : mix + row0 * MIXW) + (size_t)(32 * qg) * MIXW + 512 + head * 64; const bf16_t* gb = rest + (row0 + 32 * qg) * RESTW + R_RG + head * 64;
#pragma unroll
          for (int i = 0; i < 4; ++i) { const int q = lv + 64 * i, row = q >> 3, ch = q & 7;
            const f32x4 a0 = *(const LAS f32x4*)(stg + row * 64 + ch * 8), a1 = *(const LAS f32x4*)(stg + row * 64 + ch * 8 + 4);
            const u32x4 gw = gwv[i];
            float gv[8] = {bf_lo(gw.x), bf_hi(gw.x), bf_lo(gw.y), bf_hi(gw.y), bf_lo(gw.z), bf_hi(gw.z), bf_lo(gw.w), bf_hi(gw.w)}; float ov[8];
#pragma unroll
            for (int e = 0; e < 8; ++e) ov[e] = (e < 4 ? a0[e & 3] : a1[e & 3]) * (gv[e] * __builtin_amdgcn_rcpf(1.f + __expf(-gv[e])));
            u32x4 w; w.x = pk2(ov[0], ov[1]); w.y = pk2(ov[2], ov[3]); w.z = pk2(ov[4], ov[5]); w.w = pk2(ov[6], ov[7]);
            *(u32x4*)(ob + (size_t)row * MIXW + ch * 8) = w; } }
    }
#undef R3_ISSUE
}
constexpr int VP = 320;
constexpr int ATT_BUF = 64 * RP + 64 * VP;
constexpr int ATT_LSCR = 2 * ATT_BUF;
DI void phase_attn(const Params& p, const Grp& G, int layer, LAS unsigned char* lds, int tid, int wave, int lane, int vcu, bool dry) {
    bf16_t* mix = (bf16_t*)(p.ws + OFF_BIG + BIG_MIX); const bf16_t* rest = (const bf16_t*)(p.ws + OFF_BIG + BIG_REST);
    const int NQB = G.S / 128, nunits = G.NB * 4 * NQB, NT = G.S / 64;
    const int c = wave >> 2, qg = wave & 3, hi = lane >> 5, l31 = lane & 31, q4 = (lane & 15) >> 2, p4 = lane & 3, blk = (lane >> 4) & 1;
    float lamv, bound2;
    { const float* lp = p.lam + layer * 256; const float s1 = wave_sum(lp[lane] * lp[64 + lane]), s2 = wave_sum(lp[128 + lane] * lp[192 + lane]);
      const float lam_init = 0.8f - 0.6f * expf(-0.3f * (float)layer); lamv = expf(s1) - expf(s2) + lam_init;
      const float mq = wave_max(fabsf(p.qn[layer * 64 + lane])), mk = wave_max(fabsf(p.kn[layer * 64 + lane])); bound2 = 8.0f * mq * mk * LOG2E; }
    const float lam_init = 0.8f - 0.6f * expf(-0.3f * (float)layer);
    LAS float* lscr = (LAS float*)(lds + ATT_LSCR) + wave * 32;
    const int lrow = tid >> 4, lch = tid & 15;
    for (int u = vcu; u < nunits; u += gridDim.x) {
        const int qb = u % NQB, bh = u / NQB, h = bh & 3, b = bh >> 2; const size_t seq0 = (size_t)b * G.S; const size_t qrow0 = seq0 + (size_t)qb * 128;
        bf16x8 qf[4];
        { const bf16_t* qp = mix + (qrow0 + 32 * qg + l31) * MIXW + h * 128 + c * 64 + 8 * hi;
#pragma unroll
          for (int d0 = 0; d0 < 4; ++d0) qf[d0] = *(const bf16x8*)(qp + 16 * d0); }
        const bf16_t* kbase = rest + (seq0 + lrow) * RESTW + R_DK + h * 128 + lch * 8; const bf16_t* vbase = rest + (seq0 + lrow) * RESTW + R_DV + h * 128 + lch * 8;
        u32x4 gk0, gk1, gv0, gv1;
        gk0 = *(const u32x4*)kbase; gk1 = *(const u32x4*)(kbase + (size_t)32 * RESTW); gv0 = *(const u32x4*)vbase; gv1 = *(const u32x4*)(vbase + (size_t)32 * RESTW);
        __syncthreads();
        { LAS unsigned char* Kt = lds; LAS unsigned char* Vt = lds + 64 * RP;
          *(LAS u32x4*)(Kt + lrow * RP + lch * 16) = gk0; *(LAS u32x4*)(Kt + (lrow + 32) * RP + lch * 16) = gk1;
          *(LAS u32x4*)(Vt + lrow * VP + lch * 16) = gv0; *(LAS u32x4*)(Vt + (lrow + 32) * VP + lch * 16) = gv1; }
        __syncthreads();
        f32x16 o[4]; o[0] = f32x16{}; o[1] = f32x16{}; o[2] = f32x16{}; o[3] = f32x16{};
        float lsum = 0.f;
        for (int t = 0; t < NT; ++t) {
            if (t + 1 < NT) { const size_t adv = (size_t)(t + 1) * 64 * RESTW;
                gk0 = *(const u32x4*)(kbase + adv); gk1 = *(const u32x4*)(kbase + adv + (size_t)32 * RESTW); gv0 = *(const u32x4*)(vbase + adv); gv1 = *(const u32x4*)(vbase + adv + (size_t)32 * RESTW); }
            LAS unsigned char* Kt = lds + (t & 1) * ATT_BUF; LAS unsigned char* Vt = Kt + 64 * RP;
            bf16x8 pa[4];
#pragma unroll
            for (int rb = 0; rb < 2; ++rb) {
                f32x16 s = {};
#pragma unroll
                for (int d0 = 0; d0 < 4; ++d0) { const bf16x8 A = *(const LAS bf16x8*)(Kt + (32 * rb + l31) * RP + (c * 64 + 16 * d0 + 8 * hi) * 2); s = MFMA32(A, qf[d0], s); }
                float ps = 0.f;
#pragma unroll
                for (int r = 0; r < 16; ++r) { s[r] = __builtin_amdgcn_exp2f(s[r] - bound2); ps += s[r]; }
                lsum += ps;
                pa[2 * rb] = pack8(s, 0); pa[2 * rb + 1] = pack8(s, 1);
            }
#pragma unroll
            for (int ks = 0; ks < 4; ++ks) { const int rowa = (16 * ks + 4 * hi + q4) * VP;
#pragma unroll
                for (int cb = 0; cb < 4; ++cb) { const int colb = (32 * cb + 16 * blk + 4 * p4) * 2;
                    const bf16x8 B = cat8(vtr(Vt + rowa + colb), vtr(Vt + rowa + 8 * VP + colb)); o[cb] = MFMA32(pa[ks], B, o[cb]); } }
            if (t + 1 < NT) { LAS unsigned char* Kn = lds + ((t + 1) & 1) * ATT_BUF; LAS unsigned char* Vn = Kn + 64 * RP;
                *(LAS u32x4*)(Kn + lrow * RP + lch * 16) = gk0; *(LAS u32x4*)(Kn + (lrow + 32) * RP + lch * 16) = gk1;
                *(LAS u32x4*)(Vn + lrow * VP + lch * 16) = gv0; *(LAS u32x4*)(Vn + (lrow + 32) * VP + lch * 16) = gv1; }
            __syncthreads();
        }
        lsum += __shfl_xor(lsum, 32);
        if (hi == 0) lscr[l31] = lsum;
        __syncthreads();
        float rl[16];
#pragma unroll
        for (int r = 0; r < 16; ++r) rl[r] = __builtin_amdgcn_rcpf(lscr[crow(r, hi)]);
#pragma unroll
        for (int cb = 0; cb < 4; ++cb)
#pragma unroll
            for (int r = 0; r < 16; ++r) o[cb][r] *= rl[r];
        LAS float* ex = (LAS float*)lds + qg * 4096;
        if (c == 1) {
#pragma unroll
            for (int cb = 0; cb < 4; ++cb)
#pragma unroll
                for (int r = 0; r < 16; ++r) ex[crow(r, hi) * 128 + 32 * cb + l31] = o[cb][r];
        }
        __syncthreads();
        if (c == 0) {
            bf16_t* obase = dry ? (bf16_t*)(p.ws + OFF_DUMMY) : (mix + qrow0 * MIXW);
            float sw[4];
#pragma unroll
            for (int cb = 0; cb < 4; ++cb) sw[cb] = p.subln[layer * 128 + 32 * cb + l31] * (1.0f - lam_init);
#pragma unroll
            for (int r = 0; r < 16; ++r) {
                float a[4]; float ss = 0.f;
#pragma unroll
                for (int cb = 0; cb < 4; ++cb) { a[cb] = o[cb][r] - lamv * ex[crow(r, hi) * 128 + 32 * cb + l31]; ss += a[cb] * a[cb]; }
                ss = half_sum32(ss); const float ri = rsqrtf(ss * (1.0f / 128.0f) + EPSN);
                bf16_t* op = obase + (size_t)(32 * qg + crow(r, hi)) * MIXW + h * 128 + l31;
#pragma unroll
                for (int cb = 0; cb < 4; ++cb) op[32 * cb] = f2bf1(a[cb] * ri * sw[cb]);
            }
        }
    }
    __syncthreads();
}

DI int swz16(int row) { return ((row & 3) << 2) | ((row >> 2) & 3); }
constexpr int AT2_TILE = 16384, AT2_BUF = 2 * AT2_TILE, AT2_QS = 2 * AT2_BUF, AT2_LSCR = 131072;
template <bool SHIFT> DI void phase_attn2(const Params& p, const Grp& G, int layer, LAS unsigned char* lds, int tid, int wave, int lane, int vcu, bool dry) {
    bf16_t* mix = (bf16_t*)(p.ws + OFF_BIG + BIG_MIX); const bf16_t* rest = (const bf16_t*)(p.ws + OFF_BIG + BIG_REST);
    const int NQB = G.S / 256, nunits = G.NB * 4 * NQB, NT = G.S / 64;
    const int c = wave >> 2, qg = wave & 3, hi = lane >> 5, l31 = lane & 31, q4 = (lane & 15) >> 2, p4 = lane & 3, blk = (lane >> 4) & 1;
    float bound2 = 0.f;
    if (SHIFT) { const float mq = wave_max(fabsf(p.qn[layer * 64 + lane])), mk = wave_max(fabsf(p.kn[layer * 64 + lane])); bound2 = __uint_as_float(__builtin_amdgcn_readfirstlane(__float_as_uint(8.0f * mq * mk * LOG2E))); }
    LAS float* lscr = (LAS float*)(lds + AT2_LSCR) + wave * 64;
    const int k0 = l31 * 256 + (((8 * c + hi) ^ swz16(l31)) * 16);
    const int v0 = (4 * hi + q4) * 256 + (((2 * blk + (p4 >> 1)) ^ (hi & 3)) * 16) + 8 * (p4 & 1) + (q4 << 6);
    unsigned doff0;
    { const int row = 8 * wave + (lane >> 4); const int ch = (lane & 15) ^ swz16(row); doff0 = (unsigned)(row * RESTW + ch * 8) * 2u; }
    for (int u = vcu; u < nunits; u += gridDim.x) {
        const int qb = u % NQB, bh = u / NQB, h = bh & 3, b = bh >> 2; const size_t seq0 = (size_t)b * G.S; const size_t qrow0 = seq0 + (size_t)qb * 256;
        bf16x8 qf[2][4];
        int lq = (int)__builtin_amdgcn_mbcnt_hi(~0u, __builtin_amdgcn_mbcnt_lo(~0u, 0u)); asm volatile("" : "+v"(lq));
#pragma unroll
        for (int rbq = 0; rbq < 2; ++rbq) { const bf16_t* qp = mix + (qrow0 + 64 * qg + 32 * rbq + (lq & 31)) * MIXW + h * 128 + c * 64 + 8 * (lq >> 5);
#pragma unroll
          for (int d0 = 0; d0 < 4; ++d0) qf[rbq][d0] = *(const bf16x8*)(qp + 16 * d0); }
        LAS unsigned char* Qs = lds + AT2_QS + wave * 8192 + lane * 16;
        const bf16_t* kg = rest + seq0 * RESTW + R_DK + h * 128; const bf16_t* vg = rest + seq0 * RESTW + R_DV + h * 128;
        __syncthreads();
#define AT2_DMA(t_, buf_) do { const char* kb_ = (const char*)(kg + (size_t)(t_) * 64 * RESTW); const char* vb_ = (const char*)(vg + (size_t)(t_) * 64 * RESTW); \
            _Pragma("unroll") for (int i_ = 0; i_ < 2; ++i_) { const unsigned do_ = i_ ? ((dfl ^ 16u) + 4u * RESTW * 2u) : dfl; \
                __builtin_amdgcn_global_load_lds((const unsigned*)(kb_ + do_), (LAS unsigned*)(lds + (buf_) * AT2_BUF + (2 * wave + i_) * 1024), 16, 0, 0); \
                __builtin_amdgcn_global_load_lds((const unsigned*)(vb_ + do_), (LAS unsigned*)(lds + (buf_) * AT2_BUF + AT2_TILE + (2 * wave + i_) * 1024), 16, 0, 0); } } while (0)
        { unsigned dfl = doff0; asm volatile("" : "+v"(dfl)); AT2_DMA(0, 0); }
#pragma unroll
        for (int rbq = 0; rbq < 2; ++rbq)
#pragma unroll
            for (int d0 = 0; d0 < 4; ++d0) *(LAS bf16x8*)(Qs + (rbq * 4 + d0) * 1024) = qf[rbq][d0];
        asm volatile("s_waitcnt vmcnt(0)" ::: "memory");
        __syncthreads();
        f32x16 o[2][4];
#pragma unroll
        for (int a = 0; a < 2; ++a)
#pragma unroll
            for (int cb = 0; cb < 4; ++cb) o[a][cb] = f32x16{};
        float lsum[2] = {0.f, 0.f};
        for (int t = 0; t < NT; ++t) {
            unsigned dfl = doff0; asm volatile("" : "+v"(dfl));
            if (t + 1 < NT) AT2_DMA(t + 1, (t + 1) & 1);
            const unsigned lbase = (unsigned)(uintptr_t)lds + (unsigned)((t & 1) * AT2_BUF);
            unsigned k0l = (unsigned)k0 + lbase, v0l = (unsigned)v0 + lbase + AT2_TILE; asm volatile("" : "+v"(k0l), "+v"(v0l));
#define SB() __builtin_amdgcn_sched_barrier(0)
#define KFRAG(rb_, d0_) (*(const LAS bf16x8*)(uintptr_t)((k0l ^ (unsigned)((d0_) << 5)) + (unsigned)((rb_) * 8192)))
#define QFRAG(rbq_, d0_) (*(const LAS bf16x8*)(Qs + ((rbq_) * 4 + (d0_)) * 1024))
#define BFRAG(ks_, cb_) cat8(vtr((const LAS unsigned char*)(uintptr_t)((v0l ^ (unsigned)((cb_) << 6)) + (unsigned)((ks_) * 4096))), vtr((const LAS unsigned char*)(uintptr_t)((v0l ^ (unsigned)(((cb_) << 6) | 32)) + 2048u + (unsigned)((ks_) * 4096))))
#define CHAIN(dst_, rb_, rbq_, LDK_, LDQ_) do { asm volatile("" : "+v"(k0l), "+v"(Qs)); \
                if (LDK_) { _Pragma("unroll") for (int d0 = 0; d0 < 4; ++d0) kfs[d0] = KFRAG(rb_, d0); } \
                if (LDQ_) { _Pragma("unroll") for (int d0 = 0; d0 < 4; ++d0) qfs[d0] = QFRAG(rbq_, d0); } \
                SB(); dst_ = f32x16{}; \
                _Pragma("unroll") for (int d0 = 0; d0 < 4; ++d0) dst_ = MFMA32(kfs[d0], qfs[d0], dst_); \
                SB(); } while (0)
#define EXPACK(sc_, rbq_, p0_, p1_) do { float ps_ = 0.f; \
                _Pragma("unroll") for (int r = 0; r < 16; ++r) { sc_[r] = __builtin_amdgcn_exp2f(SHIFT ? sc_[r] - bound2 : sc_[r]); ps_ += sc_[r]; } \
                lsum[rbq_] += ps_; p0_ = pack8(sc_, 0); p1_ = pack8(sc_, 1); } while (0)
#define BLOAD(B_, ks_) do { asm volatile("" : "+v"(v0l)); _Pragma("unroll") for (int cb = 0; cb < 4; ++cb) B_[cb] = BFRAG(ks_, cb); SB(); } while (0)
#define PVMMA(B_, pA_, pB_) do { _Pragma("unroll") for (int cb = 0; cb < 4; ++cb) { o[0][cb] = MFMA32(pA_, B_[cb], o[0][cb]); o[1][cb] = MFMA32(pB_, B_[cb], o[1][cb]); } } while (0)
            {
                f32x16 s0, s1; bf16x8 pa00, pa01, pa10, pa11; bf16x8 kfs[4], qfs[4];
                CHAIN(s0, 0, 0, true, true); CHAIN(s1, 0, 1, false, true);
                EXPACK(s0, 0, pa00, pa01); EXPACK(s1, 1, pa10, pa11);
                SB();
                CHAIN(s1, 1, 1, true, false); CHAIN(s0, 1, 0, false, true);
                bf16x8 pb00, pb01, pb10, pb11; bf16x8 B[4];
                BLOAD(B, 0);
                PVMMA(B, pa00, pa10); EXPACK(s0, 0, pb00, pb01);
                SB();
                BLOAD(B, 1);
                PVMMA(B, pa01, pa11); EXPACK(s1, 1, pb10, pb11);
                SB();
                BLOAD(B, 2);
                PVMMA(B, pb00, pb10);
                SB();
                BLOAD(B, 3);
                PVMMA(B, pb01, pb11);
                SB();
            }
#undef CHAIN
#undef EXPACK
#undef BLOAD
#undef PVMMA
#undef SB
#undef KFRAG
#undef QFRAG
#undef BFRAG
            asm volatile("s_waitcnt vmcnt(0)" ::: "memory");
            __syncthreads();
        }
#undef AT2_DMA
        lsum[0] += __shfl_xor(lsum[0], 32); lsum[1] += __shfl_xor(lsum[1], 32);
        int lanev = (int)__builtin_amdgcn_mbcnt_hi(~0u, __builtin_amdgcn_mbcnt_lo(~0u, 0u)); asm volatile("" : "+v"(lanev));
        const int hiv = lanev >> 5, l31v = lanev & 31;
        if (hiv == 0) { lscr[l31v] = lsum[0]; lscr[32 + l31v] = lsum[1]; }
        __syncthreads();
        bf16_t* obase = dry ? (bf16_t*)(p.ws + OFF_DUMMY) : (mix + qrow0 * MIXW);
        float lamv, lam_init;
        { const float* lp = p.lam + layer * 256; const float s1 = wave_sum(lp[lanev] * lp[64 + lanev]), s2 = wave_sum(lp[128 + lanev] * lp[192 + lanev]);
          lam_init = layer == 0 ? 0.2f : (layer == 1 ? 0.355509068f : (layer == 2 ? 0.470713018f : 0.556058204f));
          lamv = __uint_as_float(__builtin_amdgcn_readfirstlane(__float_as_uint(expf(s1) - expf(s2) + lam_init))); }
        float sw[4];
#pragma unroll
        for (int cb = 0; cb < 4; ++cb) sw[cb] = p.subln[layer * 128 + 32 * cb + l31v] * (1.0f - lam_init);
        LAS float* ex = (LAS float*)lds + qg * 4096;
#pragma unroll
        for (int rbq = 0; rbq < 2; ++rbq) {
#pragma unroll
            for (int r = 0; r < 16; ++r) { const float rl = __builtin_amdgcn_rcpf(lscr[32 * rbq + crow(r, hiv)]);
#pragma unroll
                for (int cb = 0; cb < 4; ++cb) o[rbq][cb][r] *= rl; }
            if (c == 1) {
#pragma unroll
                for (int cb = 0; cb < 4; ++cb)
#pragma unroll
                    for (int r = 0; r < 16; ++r) ex[crow(r, hiv) * 128 + 32 * cb + l31v] = o[rbq][cb][r];
            }
            __syncthreads();
            if (c == 0) {
                LAS unsigned char* stg = lds + AT2_QS + wave * 8192;
#pragma unroll
                for (int r = 0; r < 16; ++r) {
                    float a[4]; float ss = 0.f;
#pragma unroll
                    for (int cb = 0; cb < 4; ++cb) { a[cb] = o[rbq][cb][r] - lamv * ex[crow(r, hiv) * 128 + 32 * cb + l31v]; ss += a[cb] * a[cb]; }
                    ss = half_sum32(ss); const float ri = rsqrtf(ss * (1.0f / 128.0f) + EPSN);
                    LAS bf16_t* sp = (LAS bf16_t*)(stg + crow(r, hiv) * 256) + l31v;
#pragma unroll
                    for (int cb = 0; cb < 4; ++cb) sp[32 * cb] = f2bf1(a[cb] * ri * sw[cb]);
                }
                asm volatile("s_waitcnt lgkmcnt(0)" ::: "memory");
#pragma unroll
                for (int i = 0; i < 8; ++i) { const int q = lanev + 64 * i, row = q >> 4, ch = q & 15;
                    const u32x4 v = *(const LAS u32x4*)(stg + row * 256 + ch * 16);
                    *(u32x4*)(obase + (size_t)(64 * qg + 32 * rbq + row) * MIXW + h * 128 + ch * 8) = v; }
                asm volatile("s_waitcnt lgkmcnt(0)" ::: "memory");
            }
            __syncthreads();
        }
    }
    __syncthreads();
}

#ifndef PROBE_MASK
#define PROBE_MASK 0
#endif
#ifndef PROBE_GEMM
#define PROBE_GEMM 1
#endif
#ifndef PROBE_SYNC
#define PROBE_SYNC 1
#endif
#ifndef PH_MASK
#define PH_MASK 1023
#endif
constexpr int STEPS_PER_LAYER = 8, STEPS_PER_GROUP = 1 + DEPTH * STEPS_PER_LAYER, NSTEPS = 2 * STEPS_PER_GROUP;

__global__ void __launch_bounds__(NTHREADS, 2) mega_fwd(Params p_arg) {
    typedef const __attribute__((address_space(4))) Params* KArgP;
    extern __shared__ __attribute__((aligned(16))) unsigned char lds_raw[];
    LAS unsigned char* lds = (LAS unsigned char*)lds_raw;
    const int GRID = gridDim.x; const int bx = blockIdx.x; const int vcu = (GRID % 8 == 0) ? (bx % 8) * (GRID / 8) + bx / 8 : bx;
    const int NGW = GRID * NWAVES; const int wave0 = __builtin_amdgcn_readfirstlane((int)threadIdx.x >> 6);
    cg::grid_group grid = cg::this_grid();
    volatile LAS unsigned* xst = (volatile LAS unsigned*)(lds + LDS_BYTES - 64);
    if (threadIdx.x == 0) { xst[0] = 0u; xst[1] = 0u; }
    __syncthreads();
    const XcdBarrier xbar = xcd_barrier_post((unsigned*)(p_arg.ws + OFF_CTL), xst);
    const int step_lo = p_arg.step_lo, step_hi = p_arg.step_hi;
    int step_begin = step_lo;
    if (step_begin == 0 && step_hi > 0) {
        const Params p = p_arg;
        const int lane_i = (int)threadIdx.x & 63; const Grp G0 = grp_of(0);
        phase_prep_x(p.x_in[0], (bf16_t*)(p.ws + OFF_XBA), (float*)(p.ws + OFF_RSQ1), G0.M, bx * NWAVES + wave0, NGW, lane_i);
        phase_weights(p, lds, bx * NWAVES + wave0, NGW, wave0, lane_i);
        phase_trig(p, bx * NTHREADS + (int)threadIdx.x, GRID * NTHREADS);
        if (step_hi > 1) grid.sync();
        step_begin = 1;
    }
    for (int step = step_begin; step < step_hi; ++step) {
        KArgP kq = (KArgP)__builtin_amdgcn_kernarg_segment_ptr(); asm volatile("" : "+s"(kq));
        Params p;
        p.x_in[0] = kq->x_in[0]; p.x_in[1] = kq->x_in[1]; p.p_in[0] = kq->p_in[0]; p.p_in[1] = kq->p_in[1];
        p.ln1 = nullptr; p.w_in = nullptr; p.w_out = nullptr; p.ln2 = nullptr; p.w1 = nullptr; p.w2 = nullptr; p.wg = nullptr; p.wp = nullptr;
        p.qn = kq->qn; p.kn = kq->kn; p.lam = kq->lam; p.subln = kq->subln; p.decay = kq->decay; p.gn = kq->gn;
        p.out = kq->out; p.ws = kq->ws; p.step_lo = step_lo; p.step_hi = step_hi;
        int nrep = 1; { const int sg_ = step % STEPS_PER_GROUP; const int ph_ = sg_ > 0 ? (sg_ - 1) % STEPS_PER_LAYER : 8; nrep = ((PROBE_MASK >> ph_) & 1) ? 2 : 1; }
        _Pragma("nounroll") for (int rep = 0; rep < nrep; ++rep) {
        const int wave = wave0; const int gw = bx * NWAVES + wave;
#define FRESH_LANE int lane = (int)__builtin_amdgcn_mbcnt_hi(~0u, __builtin_amdgcn_mbcnt_lo(~0u, 0u)); asm volatile("" : "+v"(lane)); int tid = wave0 * 64 + lane; (void)tid;
        const int g = step / STEPS_PER_GROUP, sg = step % STEPS_PER_GROUP; const Grp G = grp_of(g);
        bf16_t* xbA = (bf16_t*)(p.ws + OFF_XBA); bf16_t* xbB = (bf16_t*)(p.ws + OFF_XBB);
        bf16_t* mix = (bf16_t*)(p.ws + OFF_BIG + BIG_MIX); bf16_t* rest = (bf16_t*)(p.ws + OFF_BIG + BIG_REST); bf16_t* hmid = (bf16_t*)(p.ws + OFF_BIG);
        bf16_t* ptmp = (bf16_t*)(p.ws + OFF_BIG); bf16_t* pb = (bf16_t*)(p.ws + OFF_PB);
        float* rsq1 = (float*)(p.ws + OFF_RSQ1); float* rsq2 = (float*)(p.ws + OFF_RSQ2);
        float* X = p.out + (size_t)G.tok0 * DM;
        if (sg == 0) {
            if (PH_MASK & 512) { FRESH_LANE phase_prep_x(p.x_in[1], xbA, rsq1, G.M, gw, NGW, lane); }
        } else {
            const int layer = (sg - 1) / STEPS_PER_LAYER, ph = (sg - 1) % STEPS_PER_LAYER; const bool dry = rep + 1 < nrep;
            bf16_t* xin_b = (layer & 1) ? xbB : xbA; bf16_t* xoth = (layer & 1) ? xbA : xbB;
            const bf16_t* wt = (const bf16_t*)(p.ws + OFF_WT) + (size_t)layer * WL_SIZE;
            if ((PH_MASK >> ph) & 1) switch (ph) {
            case 0: { FRESH_LANE pg8::Gemm gm{xin_b, wt + WL_IN, G.M, NIN, DM}; pg8::StaticOrder S; S.init(G.M, NIN, GRID, bx); EpiProj E{mix, rest, rsq1, p.qn + layer * 64, p.kn + layer * 64, (const float*)(p.ws + OFF_TRIGD), (const float*)(p.ws + OFF_TRIGR), G.S - 1, (const LAS float*)(lds + RINV_OFF), 0};
                      build_rinv(S, rsq1, (LAS float*)(lds + RINV_OFF), tid);
                      pg8::gemm_phase<EpiProj, pg8::StaticOrder, true, true>(lds, gm, S, E, tid); } break;
            case 1: { FRESH_LANE phase_ret_kv(p, G, layer, lds, tid, wave, lane); } break;
            case 2: { FRESH_LANE phase_ret_scan(p, G, layer, tid, dry); phase_pb(p, G, layer, g, gw, NGW, lane); } break;
            case 3:
#ifndef NO_ATTN
                { int lane1 = (int)__builtin_amdgcn_mbcnt_hi(~0u, __builtin_amdgcn_mbcnt_lo(~0u, 0u)); asm volatile("" : "+v"(lane1));
                  const float mqk = wave_max(fabsf(p.qn[layer * 64 + lane1])) * wave_max(fabsf(p.kn[layer * 64 + lane1]));
                  const bool need_shift = __builtin_amdgcn_readfirstlane((int)(8.0f * mqk * LOG2E > 60.0f)) != 0;
                  if (need_shift) { int la = (int)__builtin_amdgcn_mbcnt_hi(~0u, __builtin_amdgcn_mbcnt_lo(~0u, 0u)); asm volatile("" : "+v"(la)); phase_attn(p, G, layer, lds, wave * 64 + la, wave, la, vcu, dry); }
                  else { int lb = (int)__builtin_amdgcn_mbcnt_hi(~0u, __builtin_amdgcn_mbcnt_lo(~0u, 0u)); asm volatile("" : "+v"(lb)); phase_attn2<false>(p, G, layer, lds, wave * 64 + lb, wave, lb, vcu, dry); } }
#endif
#ifndef NO_RETOUT
                { int lane2 = (int)__builtin_amdgcn_mbcnt_hi(~0u, __builtin_amdgcn_mbcnt_lo(~0u, 0u)); asm volatile("" : "+v"(lane2)); phase_ret_out(p, G, layer, lds, wave * 64 + lane2, wave, lane2, dry); }
#endif
                break;
            case 4: { FRESH_LANE pg8::Gemm gm{mix, wt + WL_OUT, G.M, DM, DM}; pg8::StaticOrder S; S.init(G.M, DM, GRID, bx);
                      EpiResid E{layer == 0 ? (g ? p.x_in[1] : p.x_in[0]) : nullptr, xin_b, xoth, rsq2};
                      pg8::gemm_phase<EpiResid, pg8::StaticOrder, true, true>(lds, gm, S, E, tid); } break;
            case 5: { FRESH_LANE pg8::Gemm gm{xoth, wt + WL_1, G.M, DFF, DM}; pg8::StaticOrder S; S.init(G.M, DFF, GRID, bx); EpiMlp1 E{hmid, rsq2, (const LAS float*)(lds + RINV_OFF), 0};
                      build_rinv(S, rsq2, (LAS float*)(lds + RINV_OFF), tid);
                      pg8::gemm_phase<EpiMlp1, pg8::StaticOrder, true, true>(lds, gm, S, E, tid); } break;
            case 6: { FRESH_LANE pg8::Gemm gm{hmid, wt + WL_2, G.M, DM, DFF}; pg8::StaticOrder S; S.init(G.M, DM, GRID, bx); EpiResid E{nullptr, xoth, xin_b, nullptr};
                      pg8::gemm_phase<EpiResid, pg8::StaticOrder, true, true>(lds, gm, S, E, tid); } break;
            case 7: { FRESH_LANE
#ifndef NO_GP
                      { int kp = PLE; asm volatile("" : "+s"(kp)); pg8::Gemm gm{pb, wt + WL_P, G.M, DM, kp}; pg8::StaticOrder S; S.init(G.M, DM, GRID, bx); EpiP E{ptmp};
                        pg8::gemm_phase<EpiP, pg8::StaticOrder, true, true>(lds, gm, S, E, tid); }
                      __syncthreads(); asm volatile("" : "+v"(tid));
#endif
#ifndef NO_GG
                      { pg8::Gemm gm{xin_b, wt + WL_G, G.M, DM, DM}; pg8::StaticOrder S; S.init(G.M, DM, GRID, bx); EpiGate E{xin_b, ptmp, xoth, rsq1, layer == DEPTH - 1 ? X : nullptr};
                        pg8::gemm_phase<EpiGate, pg8::StaticOrder, true, true>(lds, gm, S, E, tid); }
#endif
                    } break;
            }
        }
        }
        if (step + 1 < step_hi) {
            { for (int rep2 = 0; rep2 < PROBE_SYNC; ++rep2) { int t0 = wave0 * 64 + (int)__builtin_amdgcn_mbcnt_hi(~0u, __builtin_amdgcn_mbcnt_lo(~0u, 0u)); xcd_barrier(xbar, t0); } }
        }
    }
}

#ifndef PH_MASK_UNUSED
#endif
#ifndef MK_MULTI
#define MK_MULTI 0
#endif
extern "C" void kernel_launch(void* const* d_in, const int* in_sizes, int n_in, void* d_out, int out_size, void* d_ws, size_t ws_size, hipStream_t stream) {
    static int grid = 0;
    if (grid == 0) {
        if (n_in != 18 || ws_size < WS_NEED || out_size != 49152 * DM) { fprintf(stderr, "kernel_launch: unexpected sizes (n_in %d, ws %zu need %zu, out %d)\n", n_in, ws_size, (size_t)WS_NEED, out_size); grid = -1; return; }
        int dev = 0, cus = 0, per_cu = 0;
        hipGetDevice(&dev); hipDeviceGetAttribute(&cus, hipDeviceAttributeMultiprocessorCount, dev);
        if (hipFuncSetAttribute((const void*)mega_fwd, hipFuncAttributeMaxDynamicSharedMemorySize, LDS_BYTES) != hipSuccess) { fprintf(stderr, "kernel_launch: hipFuncSetAttribute failed\n"); grid = -1; return; }
        if (hipOccupancyMaxActiveBlocksPerMultiprocessor(&per_cu, (const void*)mega_fwd, NTHREADS, LDS_BYTES) != hipSuccess || per_cu < 1) { fprintf(stderr, "kernel_launch: occupancy query gave %d\n", per_cu); per_cu = 1; }
        (void)hipGetLastError();
        grid = cus * 1;
        fprintf(stderr, "kernel_launch: grid %d (per_cu %d), ws %zu need %zu\n", grid, per_cu, ws_size, (size_t)WS_NEED);
    }
    if (grid < 0) return;
    if (hipMemsetAsync((char*)d_ws + OFF_CTL, 0, CTL_BYTES, stream) != hipSuccess) { fprintf(stderr, "kernel_launch: memset failed\n"); return; }
    Params p{};
    p.x_in[0] = (const float*)d_in[0]; p.x_in[1] = (const float*)d_in[1]; p.p_in[0] = (const float*)d_in[2]; p.p_in[1] = (const float*)d_in[3];
    p.ln1 = (const float*)d_in[4]; p.w_in = (const float*)d_in[5]; p.qn = (const float*)d_in[6]; p.kn = (const float*)d_in[7]; p.lam = (const float*)d_in[8];
    p.subln = (const float*)d_in[9]; p.decay = (const float*)d_in[10]; p.gn = (const float*)d_in[11]; p.w_out = (const float*)d_in[12]; p.ln2 = (const float*)d_in[13];
    p.w1 = (const float*)d_in[14]; p.w2 = (const float*)d_in[15]; p.wg = (const float*)d_in[16]; p.wp = (const float*)d_in[17];
    p.out = (float*)d_out; p.ws = (unsigned char*)d_ws;
#if MK_MULTI
    for (int s = 0; s < NSTEPS; ++s) { p.step_lo = s; p.step_hi = s + 1; hipLaunchKernelGGL(mega_fwd, dim3(grid), dim3(NTHREADS), LDS_BYTES, stream, p); }
#else
    p.step_lo = 0; p.step_hi = NSTEPS;
    void* args[] = {&p};
    hipError_t e = hipLaunchCooperativeKernel((const void*)mega_fwd, dim3(grid), dim3(NTHREADS), args, LDS_BYTES, stream);
    if (e != hipSuccess) fprintf(stderr, "kernel_launch: cooperative launch failed: %s (grid %d)\n", hipGetErrorString(e), grid);
#endif
}
```
